# Optimizing an MI355X kernel written in HIP

```python
import jax
import jax.numpy as jnp
from jax import lax
import numpy as np

D_MODEL = 2048
BATCH = 2
SEQ = 4096
DEPTH = 1

HEAD_DIM = 128
FOX_HEADS = 6
DSA_HEADS = 6
CROSS_HEADS = 4
N_MEM = 256
FOX_WIDTH = FOX_HEADS * HEAD_DIM
DSA_WIDTH = DSA_HEADS * HEAD_DIM
CROSS_WIDTH = CROSS_HEADS * HEAD_DIM
N_BRANCHES = 3
ROPE_THETA = 500000.0
ROT_DIM = HEAD_DIM // 4
IDX_HEADS = 16
IDX_DIM = 64
IDX_ROT_DIM = IDX_DIM // 4
INDEX_TOPK = 256
Q_BLOCK = 128
N_GROUPS = 4
EXPERTS_PER_GROUP = 8
N_EXPERTS = N_GROUPS * EXPERTS_PER_GROUP
MOE_TOP_K = 2
EXPERT_FF = 1024
MOE_BLOCK = 128
EPS = 1e-6
IN_SPLITS = (FOX_WIDTH, FOX_WIDTH, FOX_WIDTH, FOX_HEADS,
             DSA_WIDTH, DSA_WIDTH, DSA_WIDTH,
             IDX_HEADS * IDX_DIM, IDX_HEADS, IDX_DIM,
             CROSS_WIDTH, N_BRANCHES * D_MODEL)
IN_WIDTH = sum(IN_SPLITS)

kernel_name = 'hybrid_fox_dsa_xattn_hmoe'


def rms_norm(x, g):
    xf = x.astype(jnp.float32)
    y = xf * lax.rsqrt(jnp.mean(xf * xf, axis=-1, keepdims=True) + EPS)
    return (y * g.astype(jnp.float32)).astype(x.dtype)


def partial_rope(x, positions, rot_dim):
    half = rot_dim // 2
    inv_freq = jnp.power(jnp.float32(ROPE_THETA), -jnp.arange(half, dtype=jnp.float32) * 2.0 / rot_dim)
    ang = positions.astype(jnp.float32)[..., None] * inv_freq
    cos = jnp.cos(ang)[:, :, None, :]
    sin = jnp.sin(ang)[:, :, None, :]
    xf = x.astype(jnp.float32)
    x1, x2, rest = xf[..., :half], xf[..., half:rot_dim], xf[..., rot_dim:]
    out = jnp.concatenate([x1 * cos - x2 * sin, x2 * cos + x1 * sin, rest], axis=-1)
    return out.astype(x.dtype)


def to_blocks(a):
    b, s = a.shape[:2]
    return jnp.moveaxis(a.reshape((b, s // Q_BLOCK, Q_BLOCK) + a.shape[2:]), 1, 0)


def from_blocks(a):
    a = jnp.moveaxis(a, 0, 1)
    return a.reshape((a.shape[0], a.shape[1] * a.shape[2]) + a.shape[3:])


def fox_attention(q, k, v, log_f):
    s_len, dh = q.shape[1], q.shape[3]
    cum = jnp.cumsum(log_f.astype(jnp.float32), axis=1)
    cum_k = jnp.moveaxis(cum, 1, 2)
    kpos = jnp.arange(s_len)
    qpos = kpos.reshape(-1, Q_BLOCK)
    scale = dh ** -0.5

    def block(args):
        qb, cqb, qp = args
        s = jnp.einsum('bqhd,bkhd->bhqk', qb, k, preferred_element_type=jnp.float32) * scale
        s = s + jnp.moveaxis(cqb, 1, 2)[..., None] - cum_k[:, :, None, :]
        s = jnp.where(kpos[None, :] <= qp[:, None], s, -jnp.inf)
        p = jax.nn.softmax(s, axis=-1)
        return jnp.einsum('bhqk,bkhd->bqhd', p.astype(v.dtype), v)

    return from_blocks(lax.map(block, (to_blocks(q), to_blocks(cum), qpos)))


def dsa_attention(q, k, v, q_idx, k_idx, w_idx):
    s_len, dh = q.shape[1], q.shape[3]
    topk = min(INDEX_TOPK, s_len // 4)
    kpos = jnp.arange(s_len)
    qpos = kpos.reshape(-1, Q_BLOCK)
    scale = dh ** -0.5
    gather = jax.vmap(lambda kb, ib: kb[ib])

    def block(args):
        qb, qib, wb, qp = args
        logits = jnp.einsum('bqjd,bkd->bqjk', qib, k_idx, preferred_element_type=jnp.float32) * IDX_DIM ** -0.5
        score = jnp.einsum('bqj,bqjk->bqk', wb.astype(jnp.float32), jax.nn.relu(logits))
        score = jnp.where((kpos[None, :] <= qp[:, None])[None], score, -jnp.inf)
        _, idx = lax.top_k(score, topk)
        valid = idx <= qp[None, :, None]
        kg = gather(k, idx)
        vg = gather(v, idx)
        s = jnp.einsum('bqhd,bqkhd->bhqk', qb, kg, preferred_element_type=jnp.float32) * scale
        s = jnp.where(valid[:, None], s, -jnp.inf)
        p = jax.nn.softmax(s, axis=-1)
        return jnp.einsum('bhqk,bqkhd->bqhd', p.astype(vg.dtype), vg)

    blocks = (to_blocks(q), to_blocks(q_idx), to_blocks(w_idx), qpos)
    return from_blocks(lax.map(block, blocks))


def cross_attention(q, k_mem, v_mem):
    s = jnp.einsum('bqhd,bmhd->bhqm', q, k_mem, preferred_element_type=jnp.float32) * q.shape[-1] ** -0.5
    p = jax.nn.softmax(s, axis=-1)
    return jnp.einsum('bhqm,bmhd->bqhd', p.astype(v_mem.dtype), v_mem)


def hier_moe(h, wg, bg, we, be, w_gate, w_up, w_down):
    b, s, d = h.shape
    n = b * s
    hf = h.reshape(n, d)
    g_logits = jnp.einsum('nd,dg->ng', hf, wg, preferred_element_type=jnp.float32) + bg.astype(jnp.float32)
    p_group = jax.nn.softmax(g_logits, axis=-1)
    grp = jnp.argmax(g_logits, axis=-1).astype(jnp.int32)
    p_sel = jnp.take_along_axis(p_group, grp[:, None], axis=1)
    e_logits = jnp.einsum('nd,de->ne', hf, we, preferred_element_type=jnp.float32) + be.astype(jnp.float32)
    e_in = jnp.take_along_axis(e_logits.reshape(n, N_GROUPS, EXPERTS_PER_GROUP), grp[:, None, None], axis=1)[:, 0]
    top_l, top_j = lax.top_k(e_in, MOE_TOP_K)
    gate = p_sel * jax.nn.softmax(top_l, axis=-1)
    eid = (grp[:, None] * EXPERTS_PER_GROUP + top_j).reshape(-1).astype(jnp.int32)
    tok = jnp.repeat(jnp.arange(n, dtype=jnp.int32), MOE_TOP_K)
    gw = gate.reshape(-1)
    a = n * MOE_TOP_K
    n_slots = -(-(a + N_EXPERTS * (MOE_BLOCK - 1)) // MOE_BLOCK) * MOE_BLOCK
    n_blocks = n_slots // MOE_BLOCK
    counts = jnp.zeros((N_EXPERTS,), jnp.int32).at[eid].add(1)
    padded = (counts + MOE_BLOCK - 1) // MOE_BLOCK * MOE_BLOCK
    pad_end = jnp.cumsum(padded)
    pad_start = pad_end - padded
    seg_start = jnp.cumsum(counts) - counts
    order = jnp.argsort(eid, stable=True)
    se = eid[order]
    dest = pad_start[se] + jnp.arange(a, dtype=jnp.int32) - seg_start[se]
    slot_tok = jnp.full((n_slots,), n, jnp.int32).at[dest].set(tok[order])
    slot_gate = jnp.zeros((n_slots,), jnp.float32).at[dest].set(gw[order])
    block_e = jnp.minimum(jnp.searchsorted(pad_end, jnp.arange(n_blocks, dtype=jnp.int32) * MOE_BLOCK, side='right'), N_EXPERTS - 1)
    h_pad = jnp.concatenate([hf, jnp.zeros((1, d), hf.dtype)], axis=0)
    xs = h_pad[slot_tok].reshape(n_blocks, MOE_BLOCK, d)

    def expert_block(args):
        xb, e = args
        hid = jax.nn.silu(xb @ w_gate[e]) * (xb @ w_up[e])
        return hid @ w_down[e]

    ys = lax.map(expert_block, (xs, block_e)).reshape(n_slots, d)
    out = jax.ops.segment_sum(ys * slot_gate[:, None].astype(ys.dtype), slot_tok, num_segments=n + 1)
    return out[:n].reshape(b, s, d)


def hybrid_layer(x, mem, positions, attn_norm_g, mem_norm_g, w_in, fox_forget_b,
                 fox_q_norm_g, fox_k_norm_g, dsa_q_norm_g, dsa_k_norm_g, idx_k_norm_g,
                 cross_q_norm_g, cross_k_norm_g, w_mem_kv, w_branch_fox, w_branch_dsa,
                 w_branch_cross, w_out, ffn_norm_g, router_group_w, router_group_b,
                 router_expert_w, router_expert_b, expert_w_gate, expert_w_up, expert_w_down):
    b, s, _ = x.shape
    h = rms_norm(x, attn_norm_g)
    proj = jnp.einsum('bsd,de->bse', h, w_in)
    offsets = [int(o) for o in np.cumsum(IN_SPLITS)[:-1]]
    fq, fk, fv, f_logit, dq, dk, dv, iq, iw, ik, cq, gates = jnp.split(proj, offsets, axis=-1)

    def heads(t, n_heads, dim):
        return t.reshape(t.shape[0], t.shape[1], n_heads, dim)

    fq = rms_norm(heads(fq, FOX_HEADS, HEAD_DIM), fox_q_norm_g)
    fk = rms_norm(heads(fk, FOX_HEADS, HEAD_DIM), fox_k_norm_g)
    log_f = jax.nn.log_sigmoid(f_logit.astype(jnp.float32) + fox_forget_b.astype(jnp.float32))
    o_fox = fox_attention(fq, fk, heads(fv, FOX_HEADS, HEAD_DIM), log_f).reshape(b, s, FOX_WIDTH)

    dq = partial_rope(rms_norm(heads(dq, DSA_HEADS, HEAD_DIM), dsa_q_norm_g), positions, ROT_DIM)
    dk = partial_rope(rms_norm(heads(dk, DSA_HEADS, HEAD_DIM), dsa_k_norm_g), positions, ROT_DIM)
    iq = partial_rope(heads(iq, IDX_HEADS, IDX_DIM), positions, IDX_ROT_DIM)
    ik = partial_rope(rms_norm(ik, idx_k_norm_g)[:, :, None, :], positions, IDX_ROT_DIM)[:, :, 0]
    iw = iw * IDX_HEADS ** -0.5
    o_dsa = dsa_attention(dq, dk, heads(dv, DSA_HEADS, HEAD_DIM), iq, ik, iw).reshape(b, s, DSA_WIDTH)

    m = rms_norm(mem, mem_norm_g)
    mk, mv = jnp.split(jnp.einsum('bmd,de->bme', m, w_mem_kv), 2, axis=-1)
    mk = rms_norm(heads(mk, CROSS_HEADS, HEAD_DIM), cross_k_norm_g)
    cq = rms_norm(heads(cq, CROSS_HEADS, HEAD_DIM), cross_q_norm_g)
    o_cross = cross_attention(cq, mk, heads(mv, CROSS_HEADS, HEAD_DIM)).reshape(b, s, CROSS_WIDTH)

    g_fox, g_dsa, g_cross = jnp.split(jax.nn.sigmoid(gates), N_BRANCHES, axis=-1)
    merged = (g_fox * (o_fox @ w_branch_fox)
              + g_dsa * (o_dsa @ w_branch_dsa)
              + g_cross * (o_cross @ w_branch_cross))
    x = x + merged @ w_out

    x = x + hier_moe(rms_norm(x, ffn_norm_g), router_group_w, router_group_b, router_expert_w,
                     router_expert_b, expert_w_gate, expert_w_up, expert_w_down)
    return x


def setup_inputs(seed: int = 0) -> dict:
    key = jax.random.key(seed)
    ks = jax.random.split(key, 32)
    f32 = jnp.float32

    def w(k, shape, fan_in):
        return jax.random.normal(k, shape, f32) * fan_in ** -0.5

    def gain(k, shape):
        return 1.0 + 0.05 * jax.random.normal(k, shape, f32)

    L, D = DEPTH, D_MODEL
    offset = jax.random.randint(ks[2], (BATCH, 1), 0, 1024, dtype=jnp.int32)
    return {
        'x': jax.random.normal(ks[0], (BATCH, SEQ, D), f32),
        'mem': jax.random.normal(ks[1], (BATCH, N_MEM, D), f32),
        'positions': offset + jnp.arange(SEQ, dtype=jnp.int32)[None, :],
        'attn_norm_g': gain(ks[3], (L, D)),
        'mem_norm_g': gain(ks[4], (L, D)),
        'w_in': w(ks[5], (L, D, IN_WIDTH), D),
        'fox_forget_b': jax.random.uniform(ks[6], (L, FOX_HEADS), f32, 1.0, 6.0),
        'fox_q_norm_g': gain(ks[7], (L, HEAD_DIM)),
        'fox_k_norm_g': gain(ks[8], (L, HEAD_DIM)),
        'dsa_q_norm_g': gain(ks[9], (L, HEAD_DIM)),
        'dsa_k_norm_g': gain(ks[10], (L, HEAD_DIM)),
        'idx_k_norm_g': gain(ks[11], (L, IDX_DIM)),
        'cross_q_norm_g': gain(ks[12], (L, HEAD_DIM)),
        'cross_k_norm_g': gain(ks[13], (L, HEAD_DIM)),
        'w_mem_kv': w(ks[14], (L, D, 2 * CROSS_WIDTH), D),
        'w_branch_fox': w(ks[15], (L, FOX_WIDTH, D), FOX_WIDTH),
        'w_branch_dsa': w(ks[16], (L, DSA_WIDTH, D), DSA_WIDTH),
        'w_branch_cross': w(ks[17], (L, CROSS_WIDTH, D), CROSS_WIDTH),
        'w_out': w(ks[18], (L, D, D), D),
        'ffn_norm_g': gain(ks[19], (L, D)),
        'router_group_w': w(ks[20], (L, D, N_GROUPS), D),
        'router_group_b': 0.01 * jax.random.normal(ks[21], (L, N_GROUPS), f32),
        'router_expert_w': w(ks[22], (L, D, N_EXPERTS), D),
        'router_expert_b': 0.01 * jax.random.normal(ks[23], (L, N_EXPERTS), f32),
        'expert_w_gate': w(ks[24], (L, N_EXPERTS, D, EXPERT_FF), D),
        'expert_w_up': w(ks[25], (L, N_EXPERTS, D, EXPERT_FF), D),
        'expert_w_down': w(ks[26], (L, N_EXPERTS, EXPERT_FF, D), EXPERT_FF),
    }


def reference(x, mem, positions, attn_norm_g, mem_norm_g, w_in, fox_forget_b,
              fox_q_norm_g, fox_k_norm_g, dsa_q_norm_g, dsa_k_norm_g, idx_k_norm_g,
              cross_q_norm_g, cross_k_norm_g, w_mem_kv, w_branch_fox, w_branch_dsa,
              w_branch_cross, w_out, ffn_norm_g, router_group_w, router_group_b,
              router_expert_w, router_expert_b, expert_w_gate, expert_w_up, expert_w_down):
    for layer in range(DEPTH):
        x = hybrid_layer(
            x, mem, positions, attn_norm_g[layer], mem_norm_g[layer], w_in[layer],
            fox_forget_b[layer], fox_q_norm_g[layer], fox_k_norm_g[layer],
            dsa_q_norm_g[layer], dsa_k_norm_g[layer], idx_k_norm_g[layer],
            cross_q_norm_g[layer], cross_k_norm_g[layer], w_mem_kv[layer],
            w_branch_fox[layer], w_branch_dsa[layer], w_branch_cross[layer], w_out[layer],
            ffn_norm_g[layer], router_group_w[layer], router_group_b[layer],
            router_expert_w[layer], router_expert_b[layer], expert_w_gate[layer],
            expert_w_up[layer], expert_w_down[layer])
    return x
```

```cpp
#include <hip/hip_runtime.h>
#include <hip/hip_cooperative_groups.h>
#include <cstdio>
#include <cstdint>
namespace cg = cooperative_groups;

#ifndef MK_N_LAUNCHES
#define MK_N_LAUNCHES 1
#endif

constexpr int BATCH = 2, SEQ = 4096, MTOK = BATCH * SEQ, DM = 2048;
constexpr int HD = 128, FOXH = 6, DSAH = 6, CRH = 4, NMEM = 256;
constexpr int FOXW = FOXH * HD, DSAW = DSAH * HD, CRW = CRH * HD;
constexpr int IDXH = 16, IDXD = 64, TOPK = 256;
constexpr int NEXP = 32, EPG = 8, NGRP = 4, FF = 1024;
constexpr int INW = 12374, N1 = 12544;
constexpr float EPS = 1e-6f;
constexpr float ROPE_THETA = 500000.0f;
constexpr int C_FQ = 0, C_FK = 768, C_FV = 1536, C_DQ = 2304, C_DK = 3072, C_DV = 3840, C_CQ = 4608, C_IQ = 5120, C_IK = 6144, C_FL = 6208, C_IW = 6214, C_G = 6272;
__host__ __device__ __forceinline__ int win_src_col(int n) {
    if (n < 2304) return n;
    if (n < 4608) return n - 2304 + 2310;
    if (n < 5120) return n - 4608 + 5718;
    if (n < 6144) return n - 5120 + 4614;
    if (n < 6208) return n - 6144 + 5654;
    if (n < 6214) return n - 6208 + 2304;
    if (n < 6230) return n - 6214 + 5638;
    if (n < 6272) return -1;
    if (n < 12416) return n - 6272 + 6230;
    return -1;
}
constexpr int MAXSLOT = 24576;

constexpr size_t MiB = 1u << 20;
constexpr size_t al256(size_t x) { return (x + 255) & ~(size_t)255; }
constexpr size_t WS_CTL = 0, CTL_ZERO_BYTES = 1 * MiB;
constexpr size_t WS_WIN = 1 * MiB;
constexpr size_t WS_WMKV = WS_WIN + (size_t)N1 * DM * 2;
constexpr size_t WS_WBF = WS_WMKV + (size_t)1024 * DM * 2;
constexpr size_t WS_WBD = WS_WBF + (size_t)DM * FOXW * 2;
constexpr size_t WS_WBC = WS_WBD + (size_t)DM * DSAW * 2;
constexpr size_t WS_WOUT = WS_WBC + (size_t)DM * CRW * 2;
constexpr size_t WS_WGU = WS_WOUT + (size_t)DM * DM * 2;
constexpr size_t WS_WD = WS_WGU + (size_t)NEXP * 2048 * DM * 2;
constexpr size_t WS_H = WS_WD + (size_t)NEXP * DM * FF * 2;
constexpr size_t WS_MEMN = WS_H + (size_t)MTOK * DM * 2;
constexpr size_t WS_MKV = WS_MEMN + (size_t)512 * DM * 2;
constexpr size_t WS_QF = WS_MKV + (size_t)512 * 1024 * 2;
constexpr size_t HSZ6 = (size_t)BATCH * 6 * SEQ * HD * 2, HSZ4 = (size_t)BATCH * 4 * SEQ * HD * 2;
constexpr size_t WS_KF = WS_QF + HSZ6, WS_VF = WS_KF + HSZ6, WS_QD = WS_VF + HSZ6, WS_KD = WS_QD + HSZ6, WS_VD = WS_KD + HSZ6;
constexpr size_t WS_QC = WS_VD + HSZ6;
constexpr size_t WS_KC = WS_QC + HSZ4;
constexpr size_t WS_VC = WS_KC + (size_t)BATCH * 4 * NMEM * HD * 2;
constexpr size_t WS_QI = WS_VC + (size_t)BATCH * 4 * NMEM * HD * 2;
constexpr size_t WS_KI = WS_QI + (size_t)MTOK * IDXH * IDXD * 2;
constexpr size_t WS_WI = WS_KI + (size_t)MTOK * IDXD * 2;
constexpr size_t WS_LOGF = WS_WI + (size_t)MTOK * IDXH * 4;
constexpr size_t WS_MASK = WS_LOGF + (size_t)BATCH * FOXH * SEQ * 4;
constexpr size_t WS_OF = WS_MASK + (size_t)MTOK * 64 * 8;
constexpr size_t WS_OD = WS_OF + (size_t)MTOK * FOXW * 2;
constexpr size_t WS_OC = WS_OD + (size_t)MTOK * DSAW * 2;
constexpr size_t WS_LTOK = WS_OC + (size_t)MTOK * CRW * 2;
constexpr size_t WS_LGATE = WS_LTOK + (size_t)NEXP * MTOK * 4;
constexpr size_t WS_RA = al256(WS_LGATE + (size_t)NEXP * MTOK * 4);
constexpr size_t RA_BYTES = (size_t)MTOK * N1 * 2;
constexpr size_t WS_PROJ = WS_RA;
constexpr size_t WS_END0 = WS_RA + RA_BYTES;
constexpr size_t WS_RB = al256(WS_END0);
constexpr size_t WS_SCORES = WS_RB;
constexpr size_t WS_M32 = WS_RB;
constexpr size_t WS_MERGED = WS_RB + (size_t)MTOK * DM * 4;
constexpr size_t WS_X1G = WS_MERGED + (size_t)MTOK * DM * 2;
constexpr size_t WS_Y = WS_RA;
constexpr size_t WS_HID = WS_RB + (size_t)MTOK * SEQ * 4;
constexpr size_t WS_END = WS_HID + (size_t)MAXSLOT * FF * 2;
static_assert(WS_X1G + (size_t)MTOK * DM * 2 <= WS_HID, "region B map");
static_assert((size_t)2 * MTOK * DM * 4 <= RA_BYTES, "Y fits region A");
constexpr int CW_CNT = 64;
constexpr int CW_ROWSS = 1024;
constexpr int CW_BAR = 16384;
static_assert(CW_ROWSS + MTOK <= CW_BAR && (CW_BAR + 3456) * 4 <= (int)CTL_ZERO_BYTES, "ctl");

constexpr int RING_BYTES = 131072;
constexpr int LDSCTL_OFF = RING_BYTES;
constexpr int LDS_BYTES = 163840;
constexpr int NWAVES = 8, NTHREADS = 512;

#define GAS __attribute__((address_space(1)))
#define LAS __attribute__((address_space(3)))
typedef unsigned short bf16;
typedef unsigned v4u __attribute__((ext_vector_type(4)));
typedef unsigned v2u __attribute__((ext_vector_type(2)));
typedef float f32x4 __attribute__((ext_vector_type(4)));
typedef float f32x16 __attribute__((ext_vector_type(16)));
typedef short bf16x8 __attribute__((ext_vector_type(8)));
#define LDS_WAIT() asm volatile("s_waitcnt lgkmcnt(0)" ::: "memory")
#define VM_WAIT() asm volatile("s_waitcnt vmcnt(0)" ::: "memory")
__device__ __forceinline__ unsigned f2bf(float f) { unsigned u = __builtin_bit_cast(unsigned, f); return (u + 0x7fffu + ((u >> 16) & 1u)) >> 16; }
__device__ __forceinline__ unsigned pk2(float lo, float hi) { return f2bf(lo) | (f2bf(hi) << 16); }
__device__ __forceinline__ float bf2f(unsigned short b) { return __builtin_bit_cast(float, (unsigned)b << 16); }
__device__ __forceinline__ float bflo(unsigned w) { return __builtin_bit_cast(float, w << 16); }
__device__ __forceinline__ float bfhi(unsigned w) { return __builtin_bit_cast(float, w & 0xffff0000u); }
__device__ __forceinline__ float wave_sum(float v) {
#pragma unroll
    for (int o = 1; o < 64; o <<= 1) v += __shfl_xor(v, o);
    return v;
}
namespace pg8 {
#define PG8_LAS __attribute__((address_space(3)))
typedef unsigned short bf16_t;
typedef short bf16x8 __attribute__((ext_vector_type(8)));
typedef float f32x4 __attribute__((ext_vector_type(4)));
typedef float f32x2 __attribute__((ext_vector_type(2)));
typedef unsigned u32x4 __attribute__((ext_vector_type(4)));
typedef unsigned u32x2 __attribute__((ext_vector_type(2)));
constexpr int BM = 256, BK = 64, HALF = 128, HTB = HALF * BK * 2  , STAGE_BYTES = 8 * HTB, NXCD = 8, WGM = 8;

__host__ __device__ __forceinline__ int lds_byte(int r, int c) { const int st = (r >> 4) * 2 + (c >> 5), rr = r & 15, cc = c & 31, ob = rr * 64 + cc * 2; return st * 1024 + (ob ^ (((ob >> 9) & 1) << 5)); }
__host__ __device__ __forceinline__ void stage_rc(int b, int& R, int& C) { const int st = b / 1024, sb = b % 1024, swz = sb ^ (((sb >> 9) & 1) << 5); R = (st >> 1) * 16 + swz / 64; C = (st & 1) * 32 + (swz % 64) / 2; }
__host__ __device__ __forceinline__ int perm32(int rho) { const int n = rho >> 4, i = rho & 15; return 8 * (i >> 2) + 4 * n + (i & 3); }

struct Unit { int pm, pn, e, aux; };

__device__ __forceinline__ void tile_order(int L, int nM, int nN, int& pm, int& pn) {
    const int nwg = nM * nN; int wgid = L;
    { const int q = nwg / NXCD, r = nwg % NXCD, xcd = wgid % NXCD, off = wgid / NXCD; wgid = (xcd < r ? xcd * (q + 1) : r * (q + 1) + (xcd - r) * q) + off; }
    const int nig = WGM * nN, gid = wgid / nig, fm = gid * WGM, gsz = (nM - fm) < WGM ? (nM - fm) : WGM;
    pm = fm + ((wgid % nig) % gsz); pn = (wgid % nig) / gsz;
}

__device__ __forceinline__ unsigned cvt_pk_bf16(float lo, float hi) { unsigned r; asm volatile("v_cvt_pk_bf16_f32 %0, %1, %2" : "=v"(r) : "v"(lo), "v"(hi)); return r; }

struct NoHook { static constexpr bool ENABLED = false; __device__ __forceinline__ bool at(int) const { return false; } __device__ __forceinline__ void operator()(f32x4 (&)[2][2][4][2], const Unit&, int, int, int, int, int) const {} };
template <class Epi, class Sched, bool ALIGN_EPI = false, bool SP2 = false, class Hook = NoHook>
__device__ __forceinline__ void gemm_phase(PG8_LAS unsigned char* lds, const int K, const Sched& S, const Epi& E, const Hook& H = Hook()) {
    const int tid = threadIdx.x, wid = __builtin_amdgcn_readfirstlane(tid >> 6), lane = tid & 63, wr = wid >> 2, wc = wid & 3, fr = lane & 15, fq = lane >> 4;
    const int nt = K / BK;
    int R0, C0, R1, C1; stage_rc(tid * 16, R0, C0); stage_rc(tid * 16 + 8192, R1, C1);
    unsigned voffB[2];
    { const int Rb0 = Epi::PERM ? ((R0 & ~31) + perm32(R0 & 31)) : R0, Rb1 = Epi::PERM ? ((R1 & ~31) + perm32(R1 & 31)) : R1;
      voffB[0] = (unsigned)(Rb0 * K + C0) * 2u; voffB[1] = (unsigned)(Rb1 * K + C1) * 2u; }
    const size_t kstep = (size_t)(BK * 2);
    const size_t hstep = (size_t)HALF * K * 2;
    const unsigned ldsw = (unsigned)wid * 1024u;
    const int aoff = lds_byte(wr * 64 + fr, fq * 8), boff = lds_byte(wc * 32 + fr, fq * 8);
#define PG8_SA(b, h) (((b) * 2 + (h)) * HTB)
#define PG8_SB(b, h) ((4 + (b) * 2 + (h)) * HTB)
#define PG8_STAGE(bufoff, gbase, v0, v1) do { \
        __builtin_amdgcn_global_load_lds((const unsigned*)((const char*)(gbase) + (v0)), (PG8_LAS unsigned*)(lds + (bufoff) + ldsw), 16, 0, 0); \
        __builtin_amdgcn_global_load_lds((const unsigned*)((const char*)(gbase) + (v1)), (PG8_LAS unsigned*)(lds + (bufoff) + ldsw + 8192), 16, 0, 0); } while (0)
#define PG8_STAGEB(bufoff, gbase) PG8_STAGE(bufoff, gbase, voffB[0], voffB[1])
#define PG8_LDA(dst, b, h) do { _Pragma("unroll") for (int m = 0; m < 4; ++m) _Pragma("unroll") for (int k = 0; k < 2; ++k) dst[m][k] = *(const PG8_LAS bf16x8*)(lds + PG8_SA(b, h) + aoff + m * 2048 + k * 1024); } while (0)
#define PG8_LDB(dst, b, h) do { _Pragma("unroll") for (int n = 0; n < 2; ++n) _Pragma("unroll") for (int k = 0; k < 2; ++k) dst[n][k] = *(const PG8_LAS bf16x8*)(lds + PG8_SB(b, h) + boff + n * 2048 + k * 1024); } while (0)
#define PG8_MMA(ai, bj, At, Bt) do { __builtin_amdgcn_s_setprio(1); _Pragma("unroll") for (int m = 0; m < 4; ++m) _Pragma("unroll") for (int n = 0; n < 2; ++n) _Pragma("unroll") for (int k = 0; k < 2; ++k) \
        acc[ai][bj][m][n] = __builtin_amdgcn_mfma_f32_16x16x32_bf16(Bt[n][k], At[m][k], acc[ai][bj][m][n], 0, 0, 0); __builtin_amdgcn_s_setprio(0); } while (0)
#define PG8_WAIT_V(n) asm volatile("s_waitcnt vmcnt(" #n ")" ::: "memory")
#define PG8_WAIT_L(n) asm volatile("s_waitcnt lgkmcnt(" #n ")" ::: "memory")
#define PG8_BAR __builtin_amdgcn_s_barrier()
#define PG8_SCHED __builtin_amdgcn_sched_barrier(0)
    Unit cur, nxt; int ui = 0;
    if (!S.next(0, cur)) return;
    f32x4 acc[2][2][4][2];
#pragma unroll
    for (int a = 0; a < 2; ++a)
#pragma unroll
        for (int b = 0; b < 2; ++b)
#pragma unroll
            for (int m = 0; m < 4; ++m)
#pragma unroll
                for (int n = 0; n < 2; ++n) acc[a][b][m][n] = (f32x4){0.f, 0.f, 0.f, 0.f};
    bf16x8 At[4][2], B0[2][2], B1[2][2];
    const char* const Ab = S.abase();
    unsigned a00 = S.arow_off(cur, R0) + (unsigned)C0 * 2u, a01 = S.arow_off(cur, R1) + (unsigned)C1 * 2u;
    unsigned a10 = S.arow_off(cur, HALF + R0) + (unsigned)C0 * 2u, a11 = S.arow_off(cur, HALF + R1) + (unsigned)C1 * 2u;
    unsigned n00, n01, n10, n11;
    const char* cB = S.bbase(cur);
    if constexpr (SP2) {
        PG8_STAGEB(PG8_SB(0, 0), cB); PG8_STAGEB(PG8_SB(0, 1), cB + hstep); PG8_STAGE(PG8_SA(0, 0), Ab, a00, a01); PG8_STAGE(PG8_SA(0, 1), Ab, a10, a11);
        if (wr == 1) PG8_BAR;
        PG8_WAIT_V(2); PG8_BAR;
        PG8_STAGEB(PG8_SB(1, 0), cB + kstep); PG8_STAGE(PG8_SA(1, 0), Ab + kstep, a00, a01); PG8_STAGEB(PG8_SB(1, 1), cB + hstep + kstep);
        PG8_WAIT_V(6); PG8_BAR;
    } else {
        PG8_STAGEB(PG8_SB(0, 0), cB); PG8_STAGE(PG8_SA(0, 0), Ab, a00, a01); PG8_STAGEB(PG8_SB(0, 1), cB + hstep); PG8_STAGE(PG8_SA(0, 1), Ab, a10, a11);
        if (wr == 1) PG8_BAR;
        PG8_WAIT_V(4); PG8_BAR;
        PG8_STAGEB(PG8_SB(1, 0), cB + kstep); PG8_STAGE(PG8_SA(1, 0), Ab + kstep, a00, a01); PG8_STAGEB(PG8_SB(1, 1), cB + hstep + kstep);
        PG8_WAIT_V(6); PG8_BAR;
    }
    for (;;) {
        const bool has_next = S.next(ui + 1, nxt);
        const char* nB = cB;
        if (has_next) { nB = S.bbase(nxt);
            int tt = tid; asm volatile("" : "+v"(tt));
            int Rn0, Cn0, Rn1, Cn1; stage_rc(tt * 16, Rn0, Cn0); stage_rc(tt * 16 + 8192, Rn1, Cn1);
            n00 = S.arow_off(nxt, Rn0) + (unsigned)Cn0 * 2u; n01 = S.arow_off(nxt, Rn1) + (unsigned)Cn1 * 2u;
            n10 = S.arow_off(nxt, HALF + Rn0) + (unsigned)Cn0 * 2u; n11 = S.arow_off(nxt, HALF + Rn1) + (unsigned)Cn1 * 2u; }
        else { n00 = a00; n01 = a01; n10 = a10; n11 = a11; }
        for (int t = 0; t < nt; t += 2) {
            const bool last = (t == nt - 2);
            const char* ak1 = Ab + (size_t)(t + 1) * kstep;
            const char* ak2 = last ? Ab : Ab + (size_t)(t + 2) * kstep;
            const char* b2 = last ? nB : cB + (size_t)(t + 2) * kstep;
            const char* ak3 = ak2 + kstep; const char* b3 = b2 + kstep;
            const unsigned x00 = last ? n00 : a00, x01 = last ? n01 : a01, x10 = last ? n10 : a10, x11 = last ? n11 : a11;
            if constexpr (Hook::ENABLED) { if (H.at(t)) { H(acc, cur, wr, wc, fr, fq, t); } __builtin_amdgcn_sched_barrier(0); }
            if constexpr (SP2) {
            PG8_LDB(B0, 0, 0); PG8_LDB(B1, 0, 1); PG8_SCHED; PG8_LDA(At, 0, 0); PG8_STAGE(PG8_SA(1, 1), ak1, a10, a11);
            PG8_WAIT_V(8); PG8_WAIT_L(0); PG8_BAR; PG8_MMA(0, 0, At, B0); PG8_MMA(0, 1, At, B1); PG8_BAR; PG8_SCHED;
            PG8_LDA(At, 0, 1); PG8_STAGEB(PG8_SB(0, 0), b2); PG8_STAGEB(PG8_SB(0, 1), b2 + hstep); PG8_STAGE(PG8_SA(0, 0), ak2, x00, x01);
            PG8_WAIT_V(8); PG8_WAIT_L(0); PG8_BAR; PG8_MMA(1, 0, At, B0); PG8_MMA(1, 1, At, B1); PG8_BAR; PG8_SCHED;
            PG8_LDB(B0, 1, 0); PG8_LDB(B1, 1, 1); PG8_SCHED; PG8_LDA(At, 1, 0); PG8_STAGE(PG8_SA(0, 1), ak2, x10, x11);
            PG8_WAIT_V(8); PG8_WAIT_L(0); PG8_BAR; PG8_MMA(0, 0, At, B0); PG8_MMA(0, 1, At, B1); PG8_BAR; PG8_SCHED;
            PG8_LDA(At, 1, 1); PG8_STAGEB(PG8_SB(1, 0), b3); PG8_STAGEB(PG8_SB(1, 1), b3 + hstep); PG8_STAGE(PG8_SA(1, 0), ak3, x00, x01);
            PG8_WAIT_V(8); PG8_WAIT_L(0); PG8_BAR; PG8_MMA(1, 0, At, B0); PG8_MMA(1, 1, At, B1); PG8_BAR; PG8_SCHED;
            } else {
            PG8_LDB(B0, 0, 0); PG8_SCHED; PG8_LDA(At, 0, 0); PG8_STAGE(PG8_SA(1, 1), ak1, a10, a11);
            PG8_WAIT_L(8); PG8_BAR; PG8_WAIT_L(0); PG8_MMA(0, 0, At, B0); PG8_BAR; PG8_SCHED;
            PG8_LDB(B1, 0, 1); PG8_STAGEB(PG8_SB(0, 0), b2);
            PG8_BAR; PG8_WAIT_L(0); PG8_MMA(0, 1, At, B1); PG8_BAR;
            PG8_LDA(At, 0, 1); PG8_STAGE(PG8_SA(0, 0), ak2, x00, x01);
            PG8_BAR; PG8_WAIT_L(0); PG8_MMA(1, 0, At, B0); PG8_BAR; PG8_SCHED;
            PG8_STAGEB(PG8_SB(0, 1), b2 + hstep);
            PG8_WAIT_V(6); PG8_BAR; PG8_MMA(1, 1, At, B1); PG8_BAR;
            PG8_LDB(B0, 1, 0); PG8_SCHED; PG8_LDA(At, 1, 0); PG8_STAGE(PG8_SA(0, 1), ak2, x10, x11);
            PG8_WAIT_L(8); PG8_BAR; PG8_WAIT_L(0); PG8_MMA(0, 0, At, B0); PG8_BAR; PG8_SCHED;
            PG8_LDB(B1, 1, 1); PG8_STAGEB(PG8_SB(1, 0), b3);
            PG8_BAR; PG8_WAIT_L(0); PG8_MMA(0, 1, At, B1); PG8_BAR;
            PG8_LDA(At, 1, 1); PG8_STAGE(PG8_SA(1, 0), ak3, x00, x01);
            PG8_BAR; PG8_WAIT_L(0); PG8_MMA(1, 0, At, B0); PG8_BAR; PG8_SCHED;
            PG8_STAGEB(PG8_SB(1, 1), b3 + hstep);
            PG8_WAIT_V(6); PG8_BAR; PG8_MMA(1, 1, At, B1); PG8_BAR;
            }
        }
        if constexpr (ALIGN_EPI) { if (wr == 0) PG8_BAR; }
        E(acc, cur, wr, wc, fr, fq);
        if (!has_next) break;
#pragma unroll
        for (int a = 0; a < 2; ++a)
#pragma unroll
            for (int b = 0; b < 2; ++b)
#pragma unroll
                for (int m = 0; m < 4; ++m)
#pragma unroll
                    for (int n = 0; n < 2; ++n) acc[a][b][m][n] = (f32x4){0.f, 0.f, 0.f, 0.f};
        cur = nxt; cB = nB; a00 = n00; a01 = n01; a10 = n10; a11 = n11; ++ui;
        if constexpr (ALIGN_EPI) { if (wr == 1) PG8_BAR; }
    }
    PG8_WAIT_V(0);
    if constexpr (!ALIGN_EPI) { if (wr == 0) PG8_BAR; }
    PG8_BAR;
#undef PG8_SA
#undef PG8_SB
#undef PG8_STAGE
#undef PG8_STAGEB
#undef PG8_LDA
#undef PG8_LDB
#undef PG8_MMA
#undef PG8_WAIT_V
#undef PG8_WAIT_L
#undef PG8_BAR
#undef PG8_SCHED
}
}
namespace lc {
using pg8::Unit; using pg8::bf16x8; using pg8::f32x4; using pg8::lds_byte;
constexpr int A_STAGE = 32768, B_STAGE = 16384, A_OFF = 0, B_OFF = 3 * A_STAGE, LDS_TOTAL = B_OFF + 2 * B_STAGE;
#define LC_LAS __attribute__((address_space(3)))
#define LC_BAR() __builtin_amdgcn_s_barrier()
template <class Epi, class Sched>
__device__ __forceinline__ void gemm_lc(LC_LAS unsigned char* lds, const int K, const Sched& S, const Epi& E) {
    constexpr int D = 4;
    int tid_ = threadIdx.x; asm volatile("" : "+v"(tid_));
    const int tid = tid_, wid = __builtin_amdgcn_readfirstlane(tid >> 6), lane = tid & 63;
    const int nt = K / 64;
    Unit cur; if (!S.next(0, cur)) return;
    if (wid < 4) {
        const int cw = wid, fr = lane & 15, fq = lane >> 4;
        const int pj = lane >> 3; const unsigned pch = (unsigned)(((lane & 7) ^ pj) * 16);
        unsigned ao[8], an[8];
#pragma unroll
        for (int i = 0; i < 8; ++i) ao[i] = S.arow_off(cur, cw * 64 + 8 * i + pj) + pch;
        const char* const Ab = S.abase();
#define LC_ISSUE_A(stage, OFF, kt) do { const char* g_ = Ab + (size_t)(kt) * 128; _Pragma("unroll") for (int i = 0; i < 8; ++i) \
            __builtin_amdgcn_global_load_lds((const unsigned*)(g_ + OFF[i]), (LC_LAS unsigned*)(lds + A_OFF + (stage) * A_STAGE + (cw * 8 + i) * 1024), 16, 0, 0); } while (0)
        f32x4 acc[4][8];
#pragma unroll
        for (int m = 0; m < 4; ++m)
#pragma unroll
            for (int n = 0; n < 8; ++n) acc[m][n] = (f32x4){0.f, 0.f, 0.f, 0.f};
        const int arow = A_OFF + (cw * 64 + fr) * 128, aoff0 = arow + ((fq ^ (fr & 7)) * 16), aoff1 = arow + (((4 + fq) ^ (fr & 7)) * 16), boff = B_OFF + (fq * 128 + fr) * 16;
        LC_ISSUE_A(0, ao, 0); LC_ISSUE_A(1, ao, 1);
        asm volatile("s_waitcnt vmcnt(8)" ::: "memory"); LC_BAR();
        int gs = 0, bs = 0, ui = 0;
        for (;;) {
            Unit nxt; const bool has_next = S.next(ui + 1, nxt);
#pragma unroll
            for (int i = 0; i < 8; ++i) an[i] = has_next ? S.arow_off(nxt, cw * 64 + 8 * i + pj) + pch : ao[i];
#pragma unroll 1
            for (int t = 0; t < nt; ++t) {
                const int s2 = gs + 2 >= 3 ? gs - 1 : gs + 2;
                const bool own = t + 2 < nt;
                const char* g2 = Ab + (size_t)(own ? t + 2 : t + 2 - nt) * 128;
                const LC_LAS unsigned char* As = lds + gs * A_STAGE; const LC_LAS unsigned char* Bp = lds + bs * B_STAGE + boff;
#pragma unroll
                for (int kk = 0; kk < 2; ++kk) {
                    bf16x8 af[4], bfr[8];
#pragma unroll
                    for (int m = 0; m < 4; ++m) af[m] = *(const LC_LAS bf16x8*)(As + (kk ? aoff1 : aoff0) + m * 2048);
#pragma unroll
                    for (int n = 0; n < 8; ++n) bfr[n] = *(const LC_LAS bf16x8*)(Bp + n * 256 + kk * 8192);
#pragma unroll
                    for (int m = 0; m < 4; ++m) {
                        __builtin_amdgcn_s_setprio(1);
#pragma unroll
                        for (int n = 0; n < 8; ++n) acc[m][n] = __builtin_amdgcn_mfma_f32_16x16x32_bf16(bfr[n], af[m], acc[m][n], 0, 0, 0);
                        __builtin_amdgcn_s_setprio(0);
                        __builtin_amdgcn_global_load_lds((const unsigned*)(g2 + (own ? ao[kk * 4 + m] : an[kk * 4 + m])), (LC_LAS unsigned*)(lds + A_OFF + s2 * A_STAGE + (cw * 8 + kk * 4 + m) * 1024), 16, 0, 0);
                        __builtin_amdgcn_sched_barrier(0);
                    }
                }
                asm volatile("s_waitcnt vmcnt(8) lgkmcnt(0)" ::: "memory"); LC_BAR();
                gs = gs == 2 ? 0 : gs + 1; bs ^= 1;
            }
            E(acc, cur, cw, fr, fq);
            if (!has_next) break;
#pragma unroll
            for (int m = 0; m < 4; ++m)
#pragma unroll
                for (int n = 0; n < 8; ++n) acc[m][n] = (f32x4){0.f, 0.f, 0.f, 0.f};
            cur = nxt; ++ui;
#pragma unroll
            for (int i = 0; i < 8; ++i) ao[i] = an[i];
        }
        asm volatile("s_waitcnt vmcnt(0)" ::: "memory");
#undef LC_ISSUE_A
    } else {
        const int ltid = tid - 256, n4 = ltid & 31, kq = ltid >> 5;
        const int pitch = S.bpitch();
        const int rot = n4 & 3;
        int wo[4];
#pragma unroll
        for (int c = 0; c < 4; ++c) wo[c] = B_OFF + (kq * 128 + 4 * n4 + ((c + rot) & 3)) * 16;
        f32x4 rb[D][8];
        Unit lu = cur; int li = 0, lk = 0; const float* lp = S.bsrc(lu, 4 * n4) + (size_t)(kq * 8) * pitch;
#define LC_LOAD(slot) do { const float* p_ = lp + (size_t)lk * 64 * pitch; _Pragma("unroll") for (int j = 0; j < 8; ++j) rb[slot][j] = *(const f32x4*)(p_ + (size_t)j * pitch); \
            if (++lk == nt) { lk = 0; Unit nu; if (S.next(li + 1, nu)) { lu = nu; ++li; lp = S.bsrc(lu, 4 * n4) + (size_t)(kq * 8) * pitch; } } } while (0)
#define LC_ROT(v) ({ f32x4 a_ = (rot & 1) ? (f32x4){(v)[1], (v)[2], (v)[3], (v)[0]} : (v); (rot & 2) ? (f32x4){a_[2], a_[3], a_[0], a_[1]} : a_; })
#define LC_WRITE(slot, stage) do { f32x4 q_[8]; _Pragma("unroll") for (int j = 0; j < 8; ++j) q_[j] = LC_ROT(rb[slot][j]); \
            _Pragma("unroll") for (int c = 0; c < 4; ++c) { pg8::u32x4 w_; \
            w_.x = pg8::cvt_pk_bf16(q_[0][c], q_[1][c]); w_.y = pg8::cvt_pk_bf16(q_[2][c], q_[3][c]); \
            w_.z = pg8::cvt_pk_bf16(q_[4][c], q_[5][c]); w_.w = pg8::cvt_pk_bf16(q_[6][c], q_[7][c]); \
            *(LC_LAS pg8::u32x4*)(lds + (stage) * B_STAGE + wo[c]) = w_; } } while (0)
        LC_LOAD(0); LC_LOAD(1); LC_LOAD(2); LC_LOAD(3);
        LC_WRITE(0, 0); LC_LOAD(0);
        asm volatile("s_waitcnt lgkmcnt(0)" ::: "memory"); LC_BAR();
        int ui = 0;
        for (;;) {
            Unit nxt; const bool has_next = S.next(ui + 1, nxt);
#pragma unroll 1
            for (int t = 0; t < nt; t += 4) {
                LC_WRITE(1, 1); LC_LOAD(1); asm volatile("s_waitcnt lgkmcnt(0)" ::: "memory"); LC_BAR();
                LC_WRITE(2, 0); LC_LOAD(2); asm volatile("s_waitcnt lgkmcnt(0)" ::: "memory"); LC_BAR();
                LC_WRITE(3, 1); LC_LOAD(3); asm volatile("s_waitcnt lgkmcnt(0)" ::: "memory"); LC_BAR();
                LC_WRITE(0, 0); LC_LOAD(0); asm volatile("s_waitcnt lgkmcnt(0)" ::: "memory"); LC_BAR();
            }
            if (!has_next) break;
            ++ui;
        }
        asm volatile("s_waitcnt vmcnt(0)" ::: "memory");
#undef LC_LOAD
#undef LC_WRITE
#undef LC_ROT
    }
    LC_BAR();
}
}
namespace att {
constexpr int D = 128;
constexpr float SCALE = 0.08838834764831845f;
constexpr float THR = 8.f;
constexpr int NW = 8, QBLK = 32, KVBLK = 64, QB = NW * QBLK;
constexpr int SHM_V = KVBLK * D * 2, SHM_K = KVBLK * D * 2;
constexpr int LDS_WS = 2 * SHM_V + 2 * SHM_K;
constexpr int LDS_BIAS = LDS_WS + NW * 64 * 4;
constexpr int LDS_BYTES = LDS_BIAS + 4096 * 4;
typedef unsigned short bf16;
typedef short bf16x8 __attribute__((ext_vector_type(8)));
typedef short s16x4 __attribute__((ext_vector_type(4)));
typedef float f32x16 __attribute__((ext_vector_type(16)));
typedef float f32x4 __attribute__((ext_vector_type(4)));
typedef unsigned u32x4 __attribute__((ext_vector_type(4)));
#define ATT_LAS __attribute__((address_space(3)))

#define KSWZ(row, colB) ((row) * 256 + ((colB) ^ (((row) & 7) << 4)))
#define SBAR() __builtin_amdgcn_sched_barrier(0)
__device__ __forceinline__ int v_st(int k, int c) { const int kk = (k & ~0xC) | ((k & 4) << 1) | ((k & 8) >> 1); return ((kk >> 3) * 4 + (c >> 5)) * 512 + ((kk & 7) * 32 + (c & 31)) * 2; }
__device__ __forceinline__ int v_rd_base(int lane) { return ((lane & 3) << 3) | (((lane >> 2) & 3) << 6) | (((lane >> 4) & 1) << 5) | (((lane >> 5) & 1) << 8); }
constexpr int v_rd_off(int d0, int ks, int half) { return d0 * 512 + ks * 4096 + half * 2048; }
__device__ __forceinline__ int crow(int r, int hi) { return (r & 3) + 8 * (r >> 2) + 4 * hi; }
__device__ __forceinline__ unsigned cvtpk(float lo, float hi) { unsigned r; asm volatile("v_cvt_pk_bf16_f32 %0, %1, %2" : "=v"(r) : "v"(lo), "v"(hi)); return r; }
__device__ __forceinline__ bf16x8 load8(const bf16* p) { return *reinterpret_cast<const bf16x8*>(p); }

__device__ __forceinline__ void mask_tile(f32x16& p0, f32x16& p1, int dq, unsigned W) {
    const float NEG = -__builtin_inff();
#pragma unroll
    for (int r = 0; r < 16; ++r) {
        const int c = (r & 3) + 8 * (r >> 2);
        if ((unsigned)(dq - c) >= W) p0[r] = NEG;
        if ((unsigned)(dq - c - 32) >= W) p1[r] = NEG;
    }
}
__device__ __forceinline__ void mask_bits(f32x16& p0, f32x16& p1, unsigned long long w, int hi) {
    const float NEG = -__builtin_inff();
    const unsigned lo = (unsigned)w >> (4 * hi), hh = (unsigned)(w >> 32) >> (4 * hi);
#pragma unroll
    for (int r = 0; r < 16; ++r) {
        const int c = (r & 3) + 8 * (r >> 2);
        if (!((lo >> c) & 1u)) p0[r] = NEG;
        if (!((hh >> c) & 1u)) p1[r] = NEG;
    }
}
__device__ __forceinline__ void partialSM(f32x16& p0, f32x16& p1, float& m_reg, float& mn, float& alpha) {
    float pmax = p0[0]; for (int r = 1; r < 16; ++r) pmax = fmaxf(pmax, p0[r]); for (int r = 0; r < 16; ++r) pmax = fmaxf(pmax, p1[r]);
    { auto rr = __builtin_amdgcn_permlane32_swap(__float_as_uint(pmax), __float_as_uint(pmax), false, false);
      pmax = fmaxf(__uint_as_float(rr[0]), __uint_as_float(rr[1])); }
    constexpr float C2 = 1.4426950408889634f * SCALE;
    if (__builtin_expect(__all((pmax - m_reg) * SCALE <= THR), 1)) { mn = m_reg; alpha = 1.f; }
    else { mn = fmaxf(m_reg, pmax); alpha = __builtin_amdgcn_exp2f((m_reg - mn) * C2); m_reg = mn; }
    const float mnL = -mn * C2;
    for (int r = 0; r < 16; ++r) p0[r] = fmaf(p0[r], C2, mnL); for (int r = 0; r < 16; ++r) p1[r] = fmaf(p1[r], C2, mnL);
    for (int r = 0; r < 16; ++r) p0[r] = __builtin_amdgcn_exp2f(p0[r]);
}
__device__ __forceinline__ void finishSM(f32x16& p0, f32x16& p1, float alpha, float& l_reg, bf16x8& pa0, bf16x8& pa1, bf16x8& pa2, bf16x8& pa3) {
    for (int r = 0; r < 16; ++r) p1[r] = __builtin_amdgcn_exp2f(p1[r]);
    float ps = 0; for (int r = 0; r < 16; ++r) ps += p0[r]; for (int r = 0; r < 16; ++r) ps += p1[r];
    { auto rr = __builtin_amdgcn_permlane32_swap(__float_as_uint(ps), __float_as_uint(ps), false, false);
      ps = __uint_as_float(rr[0]) + __uint_as_float(rr[1]); }
    l_reg = l_reg * alpha + ps;
#define PK4(P, B_, OUT) do { unsigned a0 = cvtpk(P[B_+0], P[B_+1]), a1 = cvtpk(P[B_+2], P[B_+3]);                          \
        unsigned b0 = cvtpk(P[B_+4], P[B_+5]), b1 = cvtpk(P[B_+6], P[B_+7]);                                             \
        auto r0 = __builtin_amdgcn_permlane32_swap(a0, b0, false, false); auto r1 = __builtin_amdgcn_permlane32_swap(a1, b1, false, false); \
        u32x4 w = {r0[0], r1[0], r0[1], r1[1]}; OUT = *reinterpret_cast<bf16x8*>(&w); } while (0)
    PK4(p0, 0, pa0); PK4(p0, 8, pa1); PK4(p1, 0, pa2); PK4(p1, 8, pa3);
#undef PK4
}
template <int KB, int MODE>
__device__ __forceinline__ void qkt(f32x16& p0, f32x16& p1, const char* K_lds, int r32, int hi, const bf16x8* qr, const ATT_LAS float* bias_tile) {
    if constexpr (MODE == 1) {
        const ATT_LAS float* bp = bias_tile + 4 * hi;
#pragma unroll
        for (int g = 0; g < 4; ++g) { const f32x4 a = *(const ATT_LAS f32x4*)(bp + 8 * g), b = *(const ATT_LAS f32x4*)(bp + 32 + 8 * g);
            p0[4 * g] = a[0]; p0[4 * g + 1] = a[1]; p0[4 * g + 2] = a[2]; p0[4 * g + 3] = a[3];
            p1[4 * g] = b[0]; p1[4 * g + 1] = b[1]; p1[4 * g + 2] = b[2]; p1[4 * g + 3] = b[3]; }
    } else { p0 = f32x16{}; p1 = f32x16{}; }
    const char* kb[4];
#pragma unroll
    for (int dd = 0; dd < 4; ++dd) kb[dd] = K_lds + KB * SHM_K + KSWZ(r32, (dd * 16 + hi * 8) * 2);
#pragma unroll
    for (int d0 = 0; d0 < 8; ++d0) { const char* a = kb[d0 & 3] + (d0 >> 2) * 128;
        bf16x8 b0 = *reinterpret_cast<const bf16x8*>(a);
        bf16x8 b1 = *reinterpret_cast<const bf16x8*>(a + 32 * 256);
        p0 = __builtin_amdgcn_mfma_f32_32x32x16_bf16(b0, qr[d0], p0, 0, 0, 0);
        p1 = __builtin_amdgcn_mfma_f32_32x32x16_bf16(b1, qr[d0], p1, 0, 0, 0); }
}
template <int VB>
__device__ __forceinline__ void pv_tile(f32x16* o, int vb0, bf16x8 pa0, bf16x8 pa1, bf16x8 pa2, bf16x8 pa3) {
#define TRRD(dst, off) asm volatile("ds_read_b64_tr_b16 %0, %1 offset:%2" : "=&v"(dst) : "v"(vb0), "i"(off) : "memory")
#define PV_D0(d0) do { s16x4 l0, l1, l2, l3, h0, h1, h2, h3; constexpr int b_ = VB * SHM_V + v_rd_off(d0, 0, 0); \
        TRRD(l0, b_); TRRD(h0, b_ + 2048); TRRD(l1, b_ + 4096); TRRD(h1, b_ + 6144); TRRD(l2, b_ + 8192); TRRD(h2, b_ + 10240); TRRD(l3, b_ + 12288); TRRD(h3, b_ + 14336); \
        asm volatile("s_waitcnt lgkmcnt(0)" ::: "memory"); SBAR();   \
        o[d0] = __builtin_amdgcn_mfma_f32_32x32x16_bf16(pa0, (bf16x8){l0[0], l0[1], l0[2], l0[3], h0[0], h0[1], h0[2], h0[3]}, o[d0], 0, 0, 0);   \
        o[d0] = __builtin_amdgcn_mfma_f32_32x32x16_bf16(pa1, (bf16x8){l1[0], l1[1], l1[2], l1[3], h1[0], h1[1], h1[2], h1[3]}, o[d0], 0, 0, 0);   \
        o[d0] = __builtin_amdgcn_mfma_f32_32x32x16_bf16(pa2, (bf16x8){l2[0], l2[1], l2[2], l2[3], h2[0], h2[1], h2[2], h2[3]}, o[d0], 0, 0, 0);   \
        o[d0] = __builtin_amdgcn_mfma_f32_32x32x16_bf16(pa3, (bf16x8){l3[0], l3[1], l3[2], l3[3], h3[0], h3[1], h3[2], h3[3]}, o[d0], 0, 0, 0); } while (0)
    PV_D0(0); PV_D0(1); PV_D0(2); PV_D0(3);
#undef PV_D0
#undef TRRD
}

struct BlockRef { const bf16* Q; const bf16* K; const bf16* V; bf16* O; int P0; const unsigned long long* mrow; };
struct Seam { bf16x8 qr[8]; bf16x8 st_v0, st_v1, st_k0, st_k1; };
__device__ __forceinline__ int swa_jlo(int P0, int W) { const int lowk = P0 - W + 1; return lowk > 0 ? lowk / KVBLK : 0; }
#define ROW(p, k0, rr) ((p) + (size_t)((k0) + (rr)) * D + sc)
#define VMW() asm volatile("s_waitcnt vmcnt(0)" ::: "memory")
#define VMWN(n) asm volatile("s_waitcnt vmcnt(%0)" :: "i"(n) : "memory")
#define SLOAD_H(Kp, Vp, k0) do { S.st_v0 = load8(ROW(Vp, k0, sr)); S.st_v1 = load8(ROW(Vp, k0, 32 + sr));              \
                         S.st_k0 = load8(ROW(Kp, k0, sr)); S.st_k1 = load8(ROW(Kp, k0, 32 + sr)); } while (0)
#define SWRITE_HK(bf) do { *(bf16x8*)(K_lds + (bf) * SHM_K + kws) = S.st_k0; *(bf16x8*)(K_lds + (bf) * SHM_K + kws + 32 * 256) = S.st_k1; } while (0)
#define SWRITE_HV(bf) do { *(bf16x8*)(V_lds + (bf) * SHM_V + vst0) = S.st_v0; *(bf16x8*)(V_lds + (bf) * SHM_V + vst1) = S.st_v1; } while (0)
#define SWRITE_H(bf) do { SWRITE_HV(bf); SWRITE_HK(bf); } while (0)
__device__ __forceinline__ void attn_prime(const BlockRef& cur, int W, char* lds, Seam& S) {
    const int tid = threadIdx.x, wid = __builtin_amdgcn_readfirstlane(tid >> 6), lane = tid & 63, r32 = lane & 31, hi = lane >> 5;
    const int sr = tid >> 4, sc = (tid & 15) * 8, kws = KSWZ(sr, sc * 2); char* K_lds = lds + 2 * SHM_V;
    const int kb0 = swa_jlo(cur.P0, W) * KVBLK;
    for (int d0 = 0; d0 < 8; ++d0) S.qr[d0] = load8(cur.Q + (size_t)(wid * QBLK + r32) * D + d0 * 16 + hi * 8);
    SLOAD_H(cur.K, cur.V, kb0); VMW(); SWRITE_HK(0);
    __syncthreads();
}
template <int MODE>
__device__ __forceinline__ void attn_block(const BlockRef& cur, const BlockRef& nxt, int skv, int W, int ldo, char* lds, Seam& S) {
    const int tid = threadIdx.x, wid = __builtin_amdgcn_readfirstlane(tid >> 6), lane = tid & 63, r32 = lane & 31, hi = lane >> 5;
    const int j_lo = swa_jlo(cur.P0, W);
    int j_hi = (cur.P0 + QB - 1) / KVBLK + 1; if (j_hi > skv / KVBLK) j_hi = skv / KVBLK;
    const int NT = j_hi - j_lo;
    const int kbn = swa_jlo(nxt.P0, W) * KVBLK;
    const int qlo = cur.P0 + wid * QBLK, qm = qlo + r32 - 4 * hi;
    char* V_lds = lds; char* K_lds = lds + 2 * SHM_V;
    float* ws = (float*)(lds + LDS_WS) + wid * 64; float* li_l = ws, * al_l = ws + 32;
    const ATT_LAS float* bias_l = (const ATT_LAS float*)(ATT_LAS char*)(lds + LDS_BIAS);
    float m_reg = -1e30f, l_reg = 0; f32x16 o[4] = {};
    const int sr = tid >> 4, sc = (tid & 15) * 8, vst0 = v_st(sr, sc), vst1 = v_st(32 + sr, sc), kws = KSWZ(sr, sc * 2);
    const int vb0 = (int)(uintptr_t)V_lds + v_rd_base(lane);
    const bf16* Kh = cur.K; const bf16* Vh = cur.V;
    const unsigned long long* mw = (MODE == 2) ? cur.mrow + (size_t)(wid * QBLK + r32) * 64 + j_lo : nullptr;
    unsigned long long mwA = 0, mwB = 0;
#define RESC(a) do { if (__any((a) < 1.f)) { if (hi == 0) al_l[r32] = (a); asm volatile("s_waitcnt lgkmcnt(0)" ::: "memory");              \
                     for (int d_ = 0; d_ < 4; ++d_) for (int r = 0; r < 16; ++r) o[d_][r] *= al_l[crow(r, hi)]; } } while (0)
#define KBASE(t) ((j_lo + (t)) * KVBLK)
#define BIAS_T(t) (bias_l + KBASE(t))
#define MASKT(P0_, P1_, MW_, t) do { if constexpr (MODE == 2) { mask_bits(P0_, P1_, MW_, hi); } else if constexpr (MODE != 3) { const int kb_ = KBASE(t); \
        if (kb_ + KVBLK - 1 > qlo || kb_ <= qlo + QBLK - 1 - W) mask_tile(P0_, P1_, qm - kb_, (unsigned)W); } } while (0)
#define LOADW(MW_, t) do { if constexpr (MODE == 2) { MW_ = mw[(t)]; } } while (0)
    constexpr int NQL = 8;
#define SEAM_K0() do { VMWN(NQL); SWRITE_HK(0); SBAR(); } while (0)
    f32x16 pA0, pA1, pB0, pB1; float mnA, mnB, alA, alB; bf16x8 pa0, pa1, pa2, pa3;
    SWRITE_HV(0); SBAR();
    LOADW(mwA, 0);
    if (NT > 1) { SLOAD_H(Kh, Vh, KBASE(1)); }
    SBAR(); qkt<0, MODE>(pA0, pA1, K_lds, r32, hi, S.qr, BIAS_T(0));
    MASKT(pA0, pA1, mwA, 0); partialSM(pA0, pA1, m_reg, mnA, alA);
    if (NT > 1) { VMW(); SWRITE_H(1); }
    __syncthreads();
#define HALF_STEP(PX0, PX1, mnX, alX, MWX, PY0, PY1, alY, t, KB, VB, SB) do {                                               \
        SBAR(); LOADW(MWX, t); qkt<KB, MODE>(PX0, PX1, K_lds, r32, hi, S.qr, BIAS_T(t));                                      \
        finishSM(PY0, PY1, alY, l_reg, pa0, pa1, pa2, pa3); SBAR();                                                           \
        if ((t) + 1 < NT) { SLOAD_H(Kh, Vh, KBASE((t) + 1)); SBAR(); }                                                        \
        pv_tile<VB>(o, vb0, pa0, pa1, pa2, pa3); MASKT(PX0, PX1, MWX, (t)); partialSM(PX0, PX1, m_reg, mnX, alX);             \
        __syncthreads();                                                                                                      \
        if ((t) + 1 < NT) { VMW(); SWRITE_H(SB); }                                                                            \
        RESC(alX); __syncthreads(); } while (0)
    for (int t = 1; t + 1 < NT; t += 2) {
        HALF_STEP(pB0, pB1, mnB, alB, mwB, pA0, pA1, alA, t, 1, 0, 0);
        HALF_STEP(pA0, pA1, mnA, alA, mwA, pB0, pB1, alB, t + 1, 0, 1, 1);
    }
    const bool even = (NT & 1) == 0;
    if (even) { SBAR(); LOADW(mwB, NT - 1); qkt<1, MODE>(pB0, pB1, K_lds, r32, hi, S.qr, BIAS_T(NT - 1)); SBAR(); }
    SLOAD_H(nxt.K, nxt.V, kbn); SBAR();
#pragma unroll
    for (int d0 = 0; d0 < 8; ++d0) S.qr[d0] = load8(nxt.Q + (size_t)(wid * QBLK + r32) * D + d0 * 16 + hi * 8);
    SBAR();
    finishSM(pA0, pA1, alA, l_reg, pa0, pa1, pa2, pa3); SBAR();
    pv_tile<0>(o, vb0, pa0, pa1, pa2, pa3);
    if (even) { MASKT(pB0, pB1, mwB, NT - 1); partialSM(pB0, pB1, m_reg, mnB, alB); __syncthreads(); RESC(alB);
        finishSM(pB0, pB1, alB, l_reg, pa0, pa1, pa2, pa3); SBAR(); pv_tile<1>(o, vb0, pa0, pa1, pa2, pa3); }
    SBAR(); SEAM_K0();
    if (hi == 0) li_l[r32] = l_reg; asm volatile("s_waitcnt lgkmcnt(0)" ::: "memory");
    float rli[16];
#pragma unroll
    for (int r = 0; r < 16; ++r) rli[r] = __builtin_amdgcn_rcpf(li_l[crow(r, hi)]);
    bf16* Ow = cur.O + (size_t)(wid * QBLK) * ldo;
#pragma unroll
    for (int r = 0; r < 16; ++r) { const int orow = crow(r, hi);
#pragma unroll
        for (int d0 = 0; d0 < 4; ++d0) { const float v = o[d0][r] * rli[r];
            const float vn = __shfl_xor(v, 1);
            if ((r32 & 1) == 0) *(unsigned*)(Ow + (size_t)orow * ldo + d0 * 32 + r32) = cvtpk(v, vn); } }
    __syncthreads();
#undef RESC
#undef KBASE
#undef BIAS_T
#undef MASKT
#undef LOADW
#undef SEAM_K0
#undef HALF_STEP
}
#undef ROW
#undef VMW
#undef VMWN
#undef SLOAD_H
#undef SWRITE_HK
#undef SWRITE_HV
#undef SWRITE_H
}
struct Args {
    const float* x; const float* mem; const int* positions; const float* attn_norm_g; const float* mem_norm_g; const float* w_in; const float* fox_forget_b;
    const float* fox_q_norm_g; const float* fox_k_norm_g; const float* dsa_q_norm_g; const float* dsa_k_norm_g; const float* idx_k_norm_g;
    const float* cross_q_norm_g; const float* cross_k_norm_g; const float* w_mem_kv; const float* w_branch_fox; const float* w_branch_dsa;
    const float* w_branch_cross; const float* w_out; const float* ffn_norm_g; const float* router_group_w; const float* router_group_b;
    const float* router_expert_w; const float* router_expert_b; const float* expert_w_gate; const float* expert_w_up; const float* expert_w_down;
    float* out; unsigned char* ws; int ph_lo, ph_hi, flags, pad;
};
static_assert(sizeof(Args) == 29 * 8 + 16, "Args has no padding");

struct Frame { int tid, lane, wave, G, c, vcu; };

#define XB_TMO      128
#define XB_XCNT(j)  (256  + 64 * (j))
#define XB_XSUB(j)  (1280 + 64 * (j))
#define XB_XGEN(j)  (2304 + 64 * (j))
#define XB_TOP      3328
#define XB_TOPGEN   3392
#define XCD_BAR_WORDS 3456
#define XB_SPIN_CAP (1u << 22)
__device__ __forceinline__ unsigned xb_ld(unsigned* p)              { return __hip_atomic_load(p, __ATOMIC_RELAXED, __HIP_MEMORY_SCOPE_AGENT); }
__device__ __forceinline__ unsigned xb_add(unsigned* p, unsigned v) { return __hip_atomic_fetch_add(p, v, __ATOMIC_RELAXED, __HIP_MEMORY_SCOPE_AGENT); }
__device__ __forceinline__ unsigned xb_xcc_id() { return (unsigned)__builtin_amdgcn_s_getreg((3 << 11) | 20) & 0xFu; }
#define XB_SPIN(cond, bar) do { unsigned _sp = 0; while (cond) { __builtin_amdgcn_s_sleep(1); \
    if ((++_sp & 255u) == 0u) { if (xb_ld(&(bar)[XB_TMO])) break; if (_sp > XB_SPIN_CAP) { atomicAdd(&(bar)[XB_TMO], 1u); break; } } } } while (0)
struct XcdBarrier { unsigned* bar; unsigned x; volatile LAS unsigned* st; };
__device__ __forceinline__ XcdBarrier xcd_barrier_post(unsigned* bar, volatile LAS unsigned* st) {
    XcdBarrier b; b.bar = bar; b.x = xb_xcc_id(); b.st = st;
    if (threadIdx.x == 0) (void)xb_add(&bar[XB_XCNT(b.x)], 1u);
    return b;
}
__device__ __forceinline__ void xcd_barrier_complete(unsigned* bar, unsigned x, unsigned& nloc, unsigned& nx) {
    const unsigned G = gridDim.x * gridDim.y * gridDim.z;
    unsigned sum, cnt, mine, sp = 0u;
    for (;;) {
        sum = 0u; cnt = 0u; mine = 0u;
#pragma unroll
        for (unsigned j = 0; j < 16; ++j) { const unsigned c = xb_ld(&bar[XB_XCNT(j)]); sum += c; cnt += (c > 0u) ? 1u : 0u; mine = (j == x) ? c : mine; }
        if (sum == G) break;
        __builtin_amdgcn_s_sleep(1);
        if ((++sp & 255u) == 0u) { if (xb_ld(&bar[XB_TMO])) break; if (sp > XB_SPIN_CAP) { atomicAdd(&bar[XB_TMO], 1u); break; } }
    }
    nloc = mine > 0u ? mine : 1u; nx = cnt > 0u ? cnt : 1u;
}
__device__ __forceinline__ void xcd_barrier(const XcdBarrier& b) {
    asm volatile("s_waitcnt vmcnt(0)" ::: "memory");
    __syncthreads();
    if (threadIdx.x == 0) {
        unsigned* bar = b.bar;
        __builtin_amdgcn_s_waitcnt(0);
        unsigned nloc = b.st[0], nx = b.st[1];
        if (nloc == 0u) { xcd_barrier_complete(bar, b.x, nloc, nx); b.st[0] = nloc; b.st[1] = nx; }
        const unsigned old = xb_add(&bar[XB_XSUB(b.x)], 1u);
        const unsigned gen = old / nloc;
        if (old + 1u == (gen + 1u) * nloc) {
            __builtin_amdgcn_fence(__ATOMIC_RELEASE, "agent");
            asm volatile("s_waitcnt vmcnt(0)" ::: "memory");
            const unsigned og = xb_add(&bar[XB_TOP], 1u);
            const unsigned tg = og / nx;
            if (og + 1u == (tg + 1u) * nx) xb_add(&bar[XB_TOPGEN], 1u);
            else XB_SPIN(xb_ld(&bar[XB_TOPGEN]) == tg, bar);
            __builtin_amdgcn_fence(__ATOMIC_ACQUIRE, "agent");
            xb_add(&bar[XB_XGEN(b.x)], 1u);
            asm volatile("s_waitcnt vmcnt(0)" ::: "memory");
        } else {
            XB_SPIN(xb_ld(&bar[XB_XGEN(b.x)]) == gen, bar);
            __builtin_amdgcn_fence(__ATOMIC_ACQUIRE, "agent");
            asm volatile("s_waitcnt vmcnt(0)" ::: "memory");
        }
    }
    __syncthreads();
}


struct TItem { const float* colp; bf16* WT; int srcN, k0, drow0, K; };
__device__ __forceinline__ void titem_load(const TItem& t, float (&v)[32], int lane) {
#pragma unroll
    for (int i = 0; i < 32; ++i) { const int kk = 2 * i + (lane >> 5); v[i] = t.colp ? t.colp[(size_t)(t.k0 + kk) * t.srcN] : 0.f; }
}
__device__ __forceinline__ void titem_store(const TItem& t, const float (&v)[32], LAS float* scr, int lane) {
    const int n = lane & 31;
#pragma unroll
    for (int i = 0; i < 32; ++i) { const int kk = 2 * i + (lane >> 5); scr[kk * 33 + n] = v[i]; }
    LDS_WAIT(); asm volatile("" ::: "memory");
    const int c = lane & 7;
#pragma unroll
    for (int j = 0; j < 4; ++j) { const int nn = (lane >> 3) + 8 * j; const LAS float* s = scr + (8 * c) * 33 + nn;
        v4u o; o.x = pk2(s[0 * 33], s[1 * 33]); o.y = pk2(s[2 * 33], s[3 * 33]); o.z = pk2(s[4 * 33], s[5 * 33]); o.w = pk2(s[6 * 33], s[7 * 33]);
        *(GAS v4u*)(t.WT + (size_t)(t.drow0 + nn) * t.K + t.k0 + 8 * c) = o; }
    LDS_WAIT(); asm volatile("" ::: "memory");
}
__device__ __forceinline__ void rms_row_to_bf16(const float* xrow, const float* g, bf16* orow, int lane) {
    const GAS f32x4* xr = (const GAS f32x4*)xrow + lane; const GAS f32x4* gr = (const GAS f32x4*)g + lane;
    f32x4 v[8]; float s = 0.f;
#pragma unroll
    for (int j = 0; j < 8; ++j) { v[j] = xr[64 * j]; s += (v[j].x * v[j].x + v[j].y * v[j].y) + (v[j].z * v[j].z + v[j].w * v[j].w); }
    const float rs = 1.0f / sqrtf(wave_sum(s) * (1.f / DM) + EPS);
    GAS v2u* o8 = (GAS v2u*)orow + lane;
#pragma unroll
    for (int j = 0; j < 8; ++j) { const f32x4 gg = gr[64 * j]; v2u w; w.x = pk2(v[j].x * rs * gg.x, v[j].y * rs * gg.y); w.y = pk2(v[j].z * rs * gg.z, v[j].w * rs * gg.w); o8[64 * j] = w; }
}
__device__ __forceinline__ void p0_prologue(const Args& A, const Frame& F, LAS unsigned char* lds) {
    LAS float* scr = (LAS float*)(lds + F.wave * 16384);
    const int gw = F.vcu * NWAVES + F.wave, NGW = F.G * NWAVES, lane = F.lane, n = lane & 31;
    unsigned char* ws = A.ws;
    constexpr int I_IN = 32 * (N1 / 32), I_MKV = 32 * 32, I_BF = 12 * 64, I_BC = 8 * 64, I_OUT = 32 * 64, I_GU = 32 * 64, I_D = 16 * 64;
    constexpr int T0 = I_IN, T1 = T0 + I_MKV, T2 = T1 + I_BF, T3 = T2 + I_BF, T4 = T3 + I_BC, T5 = T4 + I_OUT, T6 = T5, T7 = T6;
    auto decode = [&](int it) -> TItem { TItem t;
        if (it < T0) { const int nb = it % (N1 / 32), kb = it / (N1 / 32); const int sc = win_src_col(nb * 32 + n);
            t.colp = sc >= 0 ? A.w_in + sc : nullptr; t.srcN = INW; t.k0 = kb * 64; t.WT = (bf16*)(ws + WS_WIN); t.drow0 = nb * 32; t.K = DM; }
        else if (it < T1) { const int r = it - T0, nb = r % 32, kb = r / 32; t.colp = A.w_mem_kv + nb * 32 + n; t.srcN = 1024; t.k0 = kb * 64; t.WT = (bf16*)(ws + WS_WMKV); t.drow0 = nb * 32; t.K = DM; }
        else if (it < T2) { const int r = it - T1, nb = r % 64, kb = r / 64; t.colp = A.w_branch_fox + nb * 32 + n; t.srcN = DM; t.k0 = kb * 64; t.WT = (bf16*)(ws + WS_WBF); t.drow0 = nb * 32; t.K = DM; }
        else if (it < T3) { const int r = it - T2, nb = r % 64, kb = r / 64; t.colp = A.w_branch_dsa + nb * 32 + n - (size_t)FOXW * DM; t.srcN = DM; t.k0 = FOXW + kb * 64; t.WT = (bf16*)(ws + WS_WBF); t.drow0 = nb * 32; t.K = DM; }
        else if (it < T4) { const int r = it - T3, nb = r % 64, kb = r / 64; t.colp = A.w_branch_cross + nb * 32 + n - (size_t)(FOXW + DSAW) * DM; t.srcN = DM; t.k0 = FOXW + DSAW + kb * 64; t.WT = (bf16*)(ws + WS_WBF); t.drow0 = nb * 32; t.K = DM; }
        else if (it < T5) { const int r = it - T4, nb = r % 64, kb = r / 64; t.colp = A.w_out + nb * 32 + n; t.srcN = DM; t.k0 = kb * 64; t.WT = (bf16*)(ws + WS_WOUT); t.drow0 = nb * 32; t.K = DM; }
        else if (it < T6) { const int r = it - T5, e = r / I_GU, q = r % I_GU, nb = q % 64, kb = q / 64;
            t.colp = (n < 16 ? A.expert_w_gate : A.expert_w_up) + (size_t)e * DM * FF + 16 * nb + (n & 15); t.srcN = FF; t.k0 = kb * 64; t.WT = (bf16*)(ws + WS_WGU) + (size_t)e * 2048 * DM; t.drow0 = nb * 32; t.K = DM; }
        else { const int r = it - T6, e = r / I_D, q = r % I_D, nb = q % 64, kb = q / 64;
            t.colp = A.expert_w_down + (size_t)e * FF * DM + nb * 32 + n; t.srcN = DM; t.k0 = kb * 64; t.WT = (bf16*)(ws + WS_WD) + (size_t)e * DM * FF; t.drow0 = nb * 32; t.K = FF; }
        return t; };
    if (gw < T7) {
        float va[32], vb[32]; int it = gw; TItem ta = decode(it), tb; titem_load(ta, va, lane);
        for (;;) {
            int itn = it + NGW; bool hn = itn < T7;
            if (hn) { tb = decode(itn); titem_load(tb, vb, lane); }
            titem_store(ta, va, scr, lane);
            if (!hn) break;
            it = itn; itn = it + NGW; hn = itn < T7;
            if (hn) { ta = decode(itn); titem_load(ta, va, lane); }
            titem_store(tb, vb, scr, lane);
            if (!hn) break;
            it = itn;
        }
    }
    for (int m = gw; m < MTOK + 512; m += NGW) {
        if (m < MTOK) rms_row_to_bf16(A.x + (size_t)m * DM, A.attn_norm_g, (bf16*)(ws + WS_H) + (size_t)m * DM, lane);
        else rms_row_to_bf16(A.mem + (size_t)(m - MTOK) * DM, A.mem_norm_g, (bf16*)(ws + WS_MEMN) + (size_t)(m - MTOK) * DM, lane);
    }
}

struct Sched1 {
    int G, c; const char* H; const char* WIN; const char* WMKV; unsigned memoff;
    static constexpr int NU1 = 32 * 47, NU = NU1 + 8;
    bool tail;
    __device__ __forceinline__ bool next(int i, pg8::Unit& u) const {
        if (tail) { if (i > 0 || c >= 64) return false; u.pm = c & 31; u.pn = 47 + (c >> 5); u.e = 0; u.aux = 0; return true; }
        const int L = i * G + c; if (L >= NU) return false;
        if (L < NU1) { pg8::tile_order(L, 32, 47, u.pm, u.pn); u.e = 0; } else { const int r = L - NU1; u.pm = r >> 2; u.pn = r & 3; u.e = 1; }
        u.aux = 0; return true;
    }
    __device__ __forceinline__ const char* abase() const { return H; }
    __device__ __forceinline__ unsigned arow_off(const pg8::Unit& u, int r) const { return (u.e ? memoff : 0u) + (unsigned)(u.pm * 256 + r) * (unsigned)(DM * 2); }
    __device__ __forceinline__ const char* bbase(const pg8::Unit& u) const { return (u.e ? WMKV : WIN) + (size_t)u.pn * 256 * DM * 2; }
};
struct Epi1 {
    static constexpr bool PERM = true;
    bf16* PROJ; bf16* MKV;
    __device__ __forceinline__ void operator()(const pg8::f32x4 (&acc)[2][2][4][2], const pg8::Unit& u, int wr, int wc, int fr, int fq) const {
        bf16* base = u.e ? MKV : PROJ; const int ldc = u.e ? 1024 : N1;
        const int row0 = u.pm * 256 + wr * 64 + fr, col0 = u.pn * 256 + wc * 32 + 8 * fq;
#pragma unroll
        for (int ai = 0; ai < 2; ++ai)
#pragma unroll
            for (int m = 0; m < 4; ++m) { bf16* rowp = base + (size_t)(row0 + ai * 128 + m * 16) * ldc + col0;
#pragma unroll
                for (int bj = 0; bj < 2; ++bj) { pg8::f32x4 v0 = acc[ai][bj][m][0], v1 = acc[ai][bj][m][1];
                    if (!u.e && (u.pn > 24 || (u.pn == 24 && bj == 1))) {
#pragma unroll
                        for (int j = 0; j < 4; ++j) { v0[j] = 1.0f + __expf(-fminf(fmaxf(v0[j], -30.f), 30.f)); v1[j] = 1.0f + __expf(-fminf(fmaxf(v1[j], -30.f), 30.f)); } }
                    pg8::u32x4 w; w.x = pg8::cvt_pk_bf16(v0[0], v0[1]); w.y = pg8::cvt_pk_bf16(v0[2], v0[3]); w.z = pg8::cvt_pk_bf16(v1[0], v1[1]); w.w = pg8::cvt_pk_bf16(v1[2], v1[3]);
                    *(pg8::u32x4*)(rowp + bj * 128) = w; } }
    }
};

__device__ __forceinline__ float log_sigmoid(float z) { return fminf(z, 0.f) - log1pf(expf(-fabsf(z))); }
__device__ __forceinline__ void head_rms(const bf16* p, const float* g, int lane, float& a, float& b) {
    const unsigned w = *(const unsigned*)(p + 2 * lane); a = bflo(w); b = bfhi(w);
    const float ss = wave_sum(a * a + b * b); const float rs = 1.0f / sqrtf(ss * (1.f / 128.f) + EPS);
    a = a * rs * g[2 * lane]; b = b * rs * g[2 * lane + 1];
}
__device__ __forceinline__ void head_rms_w(unsigned w, const float2 g2, float& a, float& b) {
    a = bflo(w); b = bfhi(w);
    const float ss = wave_sum(a * a + b * b); const float rs = 1.0f / sqrtf(ss * (1.f / 128.f) + EPS);
    a = a * rs * g2.x; b = b * rs * g2.y;
}
struct RopeFreq { float f32a, f32b, f16a, f16b; };
__device__ __forceinline__ RopeFreq rope_freqs(int lane) {
    RopeFreq r; const int i0 = (2 * lane) & 15, i1 = (2 * lane + 1) & 15, l31 = lane & 31, k0 = (2 * l31) & 7, k1 = (2 * l31 + 1) & 7;
    r.f32a = powf(ROPE_THETA, -(float)i0 * 2.0f / 32.0f); r.f32b = powf(ROPE_THETA, -(float)i1 * 2.0f / 32.0f);
    r.f16a = powf(ROPE_THETA, -(float)k0 * 2.0f / 16.0f); r.f16b = powf(ROPE_THETA, -(float)k1 * 2.0f / 16.0f);
    return r;
}
__device__ __forceinline__ void p1b_row(const Args& A, int row, int lane, const RopeFreq& RF) {
    unsigned char* ws = A.ws;
    const bf16* pr = (const bf16*)(ws + WS_PROJ) + (size_t)row * N1;
    const int b = row / SEQ, s = row % SEQ;
    unsigned w[49];
#pragma unroll
    for (int j = 0; j < 49; ++j) w[j] = *(const unsigned*)(pr + 128 * j + 2 * lane);
    const float pos = (float)A.positions[row];
    const float2 gfq = *(const float2*)(A.fox_q_norm_g + 2 * lane), gfk = *(const float2*)(A.fox_k_norm_g + 2 * lane), gdq = *(const float2*)(A.dsa_q_norm_g + 2 * lane),
                 gdk = *(const float2*)(A.dsa_k_norm_g + 2 * lane), gcq = *(const float2*)(A.cross_q_norm_g + 2 * lane);
    float c32a = 1.f, s32a = 0.f, c32b = 1.f, s32b = 0.f;
    if (lane < 16) { sincosf(pos * RF.f32a, &s32a, &c32a); sincosf(pos * RF.f32b, &s32b, &c32b); }
    float c16a = 1.f, s16a = 0.f, c16b = 1.f, s16b = 0.f;
    if ((lane & 31) < 8) { sincosf(pos * RF.f16a, &s16a, &c16a); sincosf(pos * RF.f16b, &s16b, &c16b); }
#pragma unroll
    for (int h = 0; h < 6; ++h) {
        const size_t ho = ((size_t)(b * 6 + h) * SEQ + s) * HD + 2 * lane;
        float a, c;
        head_rms_w(w[h], gfq, a, c); *(unsigned*)((bf16*)(ws + WS_QF) + ho) = pk2(a, c);
        head_rms_w(w[6 + h], gfk, a, c); *(unsigned*)((bf16*)(ws + WS_KF) + ho) = pk2(a, c);
        *(unsigned*)((bf16*)(ws + WS_VF) + ho) = w[12 + h];
        *(unsigned*)((bf16*)(ws + WS_VD) + ho) = w[30 + h];
#pragma unroll
        for (int qk = 0; qk < 2; ++qk) {
            head_rms_w(w[(qk ? 24 : 18) + h], qk ? gdk : gdq, a, c);
            const float pa = __shfl_xor(a, 8), pc = __shfl_xor(c, 8);
            if (lane < 8) { a = a * c32a - pa * s32a; c = c * c32b - pc * s32b; }
            else if (lane < 16) { a = a * c32a + pa * s32a; c = c * c32b + pc * s32b; }
            *(unsigned*)((bf16*)(ws + (qk ? WS_KD : WS_QD)) + ho) = pk2(a, c);
        }
    }
#pragma unroll
    for (int h = 0; h < 4; ++h) { float a, c; head_rms_w(w[36 + h], gcq, a, c);
        *(unsigned*)((bf16*)(ws + WS_QC) + ((size_t)(b * 4 + h) * SEQ + s) * HD + 2 * lane) = pk2(a, c); }
    const int l31 = lane & 31;
#pragma unroll
    for (int hp = 0; hp < 8; ++hp) {
        float a = bflo(w[40 + hp]), c = bfhi(w[40 + hp]);
        const float pa = __shfl_xor(a, 4), pc = __shfl_xor(c, 4);
        if (l31 < 4) { a = a * c16a - pa * s16a; c = c * c16b - pc * s16b; }
        else if (l31 < 8) { a = a * c16a + pa * s16a; c = c * c16b + pc * s16b; }
        *(unsigned*)((bf16*)(ws + WS_QI) + (size_t)row * (IDXH * IDXD) + hp * 128 + 2 * lane) = pk2(a, c);
    }
    { float a = 0.f, c = 0.f; if (lane < 32) { a = bflo(w[48]); c = bfhi(w[48]); }
      const float ss = wave_sum(a * a + c * c); const float rs = 1.0f / sqrtf(ss * (1.f / 64.f) + EPS);
      if (lane < 32) { const float2 gk = *(const float2*)(A.idx_k_norm_g + 2 * lane); a = a * rs * gk.x; c = c * rs * gk.y; }
      const float pa = __shfl_xor(a, 4), pc = __shfl_xor(c, 4);
      if (lane < 4) { a = a * c16a - pa * s16a; c = c * c16b - pc * s16b; }
      else if (lane < 8) { a = a * c16a + pa * s16a; c = c * c16b + pc * s16b; }
      if (lane < 32) { const int d = 2 * lane; *(unsigned*)((bf16*)(ws + WS_KI) + ((size_t)(row >> 5) * 8 + (d >> 3)) * 256 + (row & 31) * 8 + (d & 7)) = pk2(a, c); } }
    if (lane < 16) ((float*)(ws + WS_WI))[(size_t)row * IDXH + lane] = bf2f(pr[C_IW + lane]) * 0.25f;
    if (lane < 6) ((float*)(ws + WS_LOGF))[(size_t)(b * 6 + lane) * SEQ + s] = log_sigmoid(bf2f(pr[C_FL + lane]) + A.fox_forget_b[lane]);
}
__device__ __forceinline__ void p1b_memrow(const Args& A, int mrow, int lane) {
    unsigned char* ws = A.ws; const bf16* pr = (const bf16*)(ws + WS_MKV) + (size_t)mrow * 1024; const int b = mrow / NMEM, m = mrow % NMEM;
#pragma unroll 1
    for (int h = 0; h < 4; ++h) { float a, c; head_rms(pr + h * HD, A.cross_k_norm_g, lane, a, c);
        const size_t ho = ((size_t)(b * 4 + h) * NMEM + m) * HD + 2 * lane;
        *(unsigned*)((bf16*)(ws + WS_KC) + ho) = pk2(a, c);
        *(unsigned*)((bf16*)(ws + WS_VC) + ho) = *(const unsigned*)(pr + 512 + h * HD + 2 * lane); }
}

__device__ __forceinline__ unsigned fkey(float f) { const unsigned u = __builtin_bit_cast(unsigned, f); return (u & 0x80000000u) ? ~u : (u | 0x80000000u); }
__device__ __forceinline__ void indexer_block(const Args& A, const Frame& F, LAS unsigned char* lds, int b, int rb) {
    unsigned char* ws = A.ws; const int lane = F.lane, w = F.wave, r = lane & 31, h = lane >> 5;
    const int t0 = rb * 16, ta = t0 + 2 * w;
    const bf16* QI = (const bf16*)(ws + WS_QI) + (size_t)(b * SEQ) * (IDXH * IDXD);
    const bf16* KI = (const bf16*)(ws + WS_KI) + (size_t)(b * SEQ) * IDXD;
    const float* WI = (const float*)(ws + WS_WI) + (size_t)(b * SEQ) * IDXH;
    float* SC = (float*)(ws + WS_SCORES) + (size_t)(b * SEQ) * SEQ;
    bf16x8 qa[4];
#pragma unroll
    for (int ks = 0; ks < 4; ++ks) qa[ks] = *(const bf16x8*)(QI + (size_t)(ta + (r >> 4)) * (IDXH * IDXD) + (r & 15) * IDXD + ks * 16 + 8 * h);
    float wA[8], wB[8];
#pragma unroll
    for (int q = 0; q < 8; ++q) { const int j = (q & 3) + 8 * (q >> 2) + 4 * h; wA[q] = WI[(size_t)ta * IDXH + j]; wB[q] = WI[(size_t)(ta + 1) * IDXH + j]; }
    const int NT = (A.flags & 2) ? 0 : ((t0 + 16 + 63) >> 6);
    LAS unsigned char* kring = lds + LDSCTL_OFF + 4096;
    const int tid = F.tid;
#define IDX_STAGE(tile_, buf_) __builtin_amdgcn_global_load_lds((const unsigned*)((const char*)KI + (size_t)(tile_) * 8192 + tid * 16), (LAS unsigned*)(kring + (buf_) * 8192 + w * 1024), 16, 0, 0)
    LAS unsigned* rowA = (LAS unsigned*)(lds + w * 16384);
    for (int j = NT >> 2; j < 16; ++j) *(LAS v4u*)(rowA + (j * 64 + lane) * 4) = (v4u){0u, 0u, 0u, 0u};
    __builtin_amdgcn_s_barrier();
    if (NT > 0) IDX_STAGE(0, 0);
#pragma unroll 1
    for (int tile = 0; tile < NT; ++tile) {
        const int kb = tile * 64;
        asm volatile("s_waitcnt vmcnt(0)" ::: "memory"); __builtin_amdgcn_s_barrier();
        if (tile + 1 < NT) IDX_STAGE(tile + 1, (tile + 1) & 1);
        const LAS unsigned char* kt = kring + (tile & 1) * 8192 + (h * 32 + r) * 16;
        bf16x8 k0[4], k1[4];
#pragma unroll
        for (int ks = 0; ks < 4; ++ks) { k0[ks] = *(const LAS bf16x8*)(kt + ks * 1024); k1[ks] = *(const LAS bf16x8*)(kt + 4096 + ks * 1024); }
        f32x16 p0 = {}, p1 = {};
#pragma unroll
        for (int ks = 0; ks < 4; ++ks) { p0 = __builtin_amdgcn_mfma_f32_32x32x16_bf16(qa[ks], k0[ks], p0, 0, 0, 0); p1 = __builtin_amdgcn_mfma_f32_32x32x16_bf16(qa[ks], k1[ks], p1, 0, 0, 0); }
        float sA0 = 0.f, sB0 = 0.f, sA1 = 0.f, sB1 = 0.f;
#pragma unroll
        for (int q = 0; q < 8; ++q) { sA0 += wA[q] * fmaxf(p0[q], 0.f); sB0 += wB[q] * fmaxf(p0[8 + q], 0.f); sA1 += wA[q] * fmaxf(p1[q], 0.f); sB1 += wB[q] * fmaxf(p1[8 + q], 0.f); }
        sA0 += __shfl_xor(sA0, 32); sB0 += __shfl_xor(sB0, 32); sA1 += __shfl_xor(sA1, 32); sB1 += __shfl_xor(sB1, 32);
        if (h) { float* dst = SC + (size_t)(ta + 1) * SEQ + kb + r; dst[0] = sB0; dst[32] = sB1; }
        else { LAS unsigned* d = rowA + ((tile >> 2) * 64 + r) * 4 + (tile & 3);
            d[0] = kb + r <= ta ? fkey(sA0) : 0u; d[128] = kb + 32 + r <= ta ? fkey(sA1) : 0u; }
    }
#undef IDX_STAGE
    VM_WAIT();
#define WAVE_COUNT(c_) ({ int tot_ = 0; _Pragma("unroll") for (int bb = 0; bb < 7; ++bb) tot_ += __popcll(__ballot(((c_) >> bb) & 1)) << bb; tot_; })
#define WAVE_COUNT3(c_) ({ int tot_ = 0; _Pragma("unroll") for (int bb = 0; bb < 3; ++bb) tot_ += __popcll(__ballot(((c_) >> bb) & 1)) << bb; tot_; })
    LAS unsigned* rowl = (LAS unsigned*)(lds + w * 16384);
    LAS unsigned* lst = (LAS unsigned*)(lds + LDSCTL_OFF + 20480 + w * 1536);
    float fb[64];
    { const float* srowB = SC + (size_t)(ta + 1) * SEQ + lane;
#pragma unroll
      for (int i = 0; i < 64; ++i) fb[i] = srowB[i * 64]; }
#pragma unroll 1
    for (int tl = (A.flags & 1) ? 2 : 0; tl < 2; ++tl) {
        const int t = ta + tl;
        unsigned long long myword = 0ull;
        if (t + 1 <= TOPK) {
            const int nb = t + 1 - lane * 64; myword = nb <= 0 ? 0ull : (nb >= 64 ? ~0ull : ((1ull << nb) - 1ull));
        } else {
            if (tl) {
#pragma unroll
                for (int j = 0; j < 16; ++j) { v4u q;
#pragma unroll
                    for (int e = 0; e < 4; ++e) { const int key = 64 * (4 * j + e) + lane; const unsigned k = fkey(fb[4 * j + e]); q[e] = key <= t ? k : 0u; }
                    *(LAS v4u*)(rowl + (j * 64 + lane) * 4) = q; }
            }
            LDS_WAIT();
            unsigned T = 0u; bool exact = false;
            int mx = -1, G = 0;
#pragma unroll 1
            for (int bit = 31; bit >= 0; --bit) {
                if (bit == 17) {
                    const unsigned Thi = T + (1u << 18);
#pragma unroll
                    for (int i = 0; i < 6; ++i) lst[i * 64 + lane] = 0u;
                    int g = 0, nc = 0;
#pragma unroll 4
                    for (int j = 0; j < 16; ++j) { const v4u q = *(const LAS v4u*)(rowl + (j * 64 + lane) * 4);
#pragma unroll
                        for (int e = 0; e < 4; ++e) { const unsigned k = q[e]; g += (k >= Thi) ? 1 : 0; const bool cnd = k >= T && k < Thi;
                            if (cnd && nc < 6) lst[nc * 64 + lane] = k;
                            nc += cnd ? 1 : 0; } }
                    LDS_WAIT();
                    if (__ballot(nc > 6) == 0ull) { G = WAVE_COUNT(g); mx = 0; }
                }
                const unsigned cand = T | (1u << bit); int cnt;
                if (mx >= 0) { int c = 0;
#pragma unroll
                    for (int i = 0; i < 6; ++i) c += (lst[i * 64 + lane] >= cand) ? 1 : 0;
                    cnt = G + WAVE_COUNT3(c);
                } else { int c = 0;
#pragma unroll 8
                    for (int j = 0; j < 16; ++j) { const v4u q = *(const LAS v4u*)(rowl + (j * 64 + lane) * 4);
                        c += ((q.x >= cand) ? 1 : 0) + ((q.y >= cand) ? 1 : 0) + ((q.z >= cand) ? 1 : 0) + ((q.w >= cand) ? 1 : 0); }
                    cnt = WAVE_COUNT(c); }
                if (cnt >= TOPK) { T = cand; if (cnt == TOPK) { exact = true; break; } }
            }
            const unsigned thr = exact ? T - 1u : T;
            int g0 = 0;
#pragma unroll 4
            for (int j = 0; j < 16; ++j) { const v4u q = *(const LAS v4u*)(rowl + (j * 64 + lane) * 4);
                g0 += ((q.x > thr) ? 1 : 0) + ((q.y > thr) ? 1 : 0) + ((q.z > thr) ? 1 : 0) + ((q.w > thr) ? 1 : 0); }
            int need = TOPK - WAVE_COUNT(g0);
#pragma unroll 1
            for (int j = 0; j < 16; ++j) { const v4u q = *(const LAS v4u*)(rowl + (j * 64 + lane) * 4);
#pragma unroll
                for (int e = 0; e < 4; ++e) {
                    const unsigned long long eq = __ballot(q[e] == thr); unsigned long long bal = __ballot(q[e] > thr);
                    if (eq != 0ull && need > 0) { const int pc = __popcll(eq);
                        if (pc <= need) { bal |= eq; need -= pc; }
                        else { const int rank = __popcll(eq & ((1ull << lane) - 1ull)); bal |= __ballot(((eq >> lane) & 1ull) && rank < need); need = 0; } }
                    if (lane == 4 * j + e) myword = bal; } }
        }
        ((unsigned long long*)(ws + WS_MASK))[(size_t)(b * SEQ + t) * 64 + lane] = myword;
    }
#undef WAVE_COUNT
#undef WAVE_COUNT3
}

__device__ __forceinline__ void fox_bias_scan(const float* logf_bh, char* lds, const Frame& F) {
    const int tid = F.tid, lane = F.lane, w = F.wave;
    float* wsum = (float*)(lds + att::LDS_WS);
    float v[8];
    { const f32x4 a = *(const f32x4*)(logf_bh + 8 * tid), c = *(const f32x4*)(logf_bh + 8 * tid + 4); v[0] = a.x; v[1] = a.y; v[2] = a.z; v[3] = a.w; v[4] = c.x; v[5] = c.y; v[6] = c.z; v[7] = c.w; }
#pragma unroll
    for (int j = 1; j < 8; ++j) v[j] += v[j - 1];
    float inc = v[7];
#pragma unroll
    for (int o = 1; o < 64; o <<= 1) { const float t = __shfl_up(inc, o); if (lane >= o) inc += t; }
    if (lane == 63) wsum[w] = inc;
    __syncthreads();
    float off = inc - v[7];
    for (int k = 0; k < w; ++k) off += wsum[k];
    float* bias = (float*)(lds + att::LDS_BIAS);
    constexpr float NIS = -1.0f / att::SCALE;
    f32x4 o0, o1; o0.x = (off + v[0]) * NIS; o0.y = (off + v[1]) * NIS; o0.z = (off + v[2]) * NIS; o0.w = (off + v[3]) * NIS;
    o1.x = (off + v[4]) * NIS; o1.y = (off + v[5]) * NIS; o1.z = (off + v[6]) * NIS; o1.w = (off + v[7]) * NIS;
    *(f32x4*)(bias + 8 * tid) = o0; *(f32x4*)(bias + 8 * tid + 4) = o1;
    __syncthreads();
}
__device__ __forceinline__ att::BlockRef make_ref(const Args& A, int kind, int item, int pass) {
    unsigned char* ws = A.ws; att::BlockRef r;
    if (kind < 2) { const int bh = item >> 3, x = item & 7, qb = pass ? 15 - x : x, b = bh / 6, h = bh % 6;
        const size_t ho = ((size_t)bh * SEQ) * HD;
        r.Q = (const bf16*)(ws + (kind ? WS_QD : WS_QF)) + ho + (size_t)qb * 256 * HD; r.K = (const bf16*)(ws + (kind ? WS_KD : WS_KF)) + ho; r.V = (const bf16*)(ws + (kind ? WS_VD : WS_VF)) + ho;
        r.O = (bf16*)(ws + WS_OF) + ((size_t)(b * SEQ + qb * 256)) * DM + (kind ? FOXW : 0) + h * HD; r.P0 = qb * 256;
        r.mrow = (const unsigned long long*)(ws + WS_MASK) + (size_t)(b * SEQ + qb * 256) * 64; }
    else { const int bh = item >> 3, x = item & 7, qb = 2 * x + pass, b = bh / 4, h = bh % 4;
        r.Q = (const bf16*)(ws + WS_QC) + ((size_t)bh * SEQ + (size_t)qb * 256) * HD; r.K = (const bf16*)(ws + WS_KC) + (size_t)bh * NMEM * HD; r.V = (const bf16*)(ws + WS_VC) + (size_t)bh * NMEM * HD;
        r.O = (bf16*)(ws + WS_OF) + ((size_t)(b * SEQ + qb * 256)) * DM + FOXW + DSAW + h * HD; r.P0 = 1 << 20; r.mrow = nullptr; }
    return r;
}
template <int MODE, int KIND>
__device__ __forceinline__ void attn_stream(const Args& A, const Frame& F, char* lds, int first, int nitems) {
    constexpr int W = 1 << 30; constexpr int SKV = KIND == 2 ? NMEM : SEQ; constexpr int LDO = DM;
    int L = first; if (L >= nitems) return;
    int pass = 0, cur_bh = -1;
    att::BlockRef cur = make_ref(A, KIND, L, 0);
    att::Seam S;
    att::attn_prime(cur, W, lds, S);
    for (;;) {
        const bool more_pass = pass == 0, more_item = L + F.G < nitems, last = !more_pass && !more_item;
        int passn = pass + 1, Ln = L;
        if (!more_pass) { passn = 0; Ln = more_item ? L + F.G : L; }
        const att::BlockRef nxt = last ? cur : make_ref(A, KIND, Ln, passn);
        if constexpr (MODE == 1) { const int bh = L >> 3; if (bh != cur_bh) { fox_bias_scan((const float*)(A.ws + WS_LOGF) + (size_t)bh * SEQ, lds, F); cur_bh = bh; } }
        att::attn_block<MODE>(cur, nxt, SKV, W, LDO, lds, S);
        if (last) break;
        cur = nxt; pass = passn; L = Ln;
    }
}

struct SchedRows {
    int G, c, nN, K; const char* Ap; const char* Bp;
    __device__ __forceinline__ bool next(int i, pg8::Unit& u) const { const int L = i * G + c; if (L >= 32 * nN) return false; pg8::tile_order(L, 32, nN, u.pm, u.pn); u.e = 0; u.aux = 0; return true; }
    __device__ __forceinline__ const char* abase() const { return Ap; }
    __device__ __forceinline__ unsigned arow_off(const pg8::Unit& u, int r) const { return (unsigned)(u.pm * 256 + r) * (unsigned)(K * 2); }
    __device__ __forceinline__ const char* bbase(const pg8::Unit& u) const { return Bp + (size_t)u.pn * 256 * K * 2; }
};
__device__ __forceinline__ pg8::f32x4 gate4(const bf16* p) { const v2u gw = *(const v2u*)p; pg8::f32x4 g; g[0] = bflo(gw.x); g[1] = bfhi(gw.x); g[2] = bflo(gw.y); g[3] = bfhi(gw.y); return g; }
struct HookMerge {
    static constexpr bool ENABLED = true; const bf16* PROJ;
    __device__ __forceinline__ bool at(int t) const { return t == 12 || t == 24; }
    __device__ __forceinline__ void operator()(pg8::f32x4 (&acc)[2][2][4][2], const pg8::Unit& u, int wr, int wc, int fr, int fq, int t) const {
        asm volatile("" : "+v"(fr), "+v"(fq));
        const int row0 = u.pm * 256 + wr * 64 + fr, col0 = u.pn * 256 + wc * 32 + 4 * fq, ga = (t == 12) ? 0 : 1;
#pragma unroll
        for (int ai = 0; ai < 2; ++ai)
#pragma unroll
            for (int m = 0; m < 4; ++m) { const bf16* gp = PROJ + (size_t)(row0 + ai * 128 + m * 16) * N1 + C_G + ga * DM + col0;
#pragma unroll
                for (int bj = 0; bj < 2; ++bj)
#pragma unroll
                    for (int n = 0; n < 2; ++n) { const pg8::f32x4 ea = gate4(gp + bj * 128 + n * 16), eb = gate4(gp + DM + bj * 128 + n * 16);
#pragma unroll
                        for (int j = 0; j < 4; ++j) acc[ai][bj][m][n][j] *= eb[j] * __builtin_amdgcn_rcpf(ea[j]); }
                if (m == 3) asm volatile("" ::: "memory"); }
    }
};
struct Epi3 {
    static constexpr bool PERM = false;
    const bf16* PROJ; bf16* MERGED;
    __device__ __forceinline__ void operator()(const pg8::f32x4 (&acc)[2][2][4][2], const pg8::Unit& u, int wr, int wc, int fr, int fq) const {
        asm volatile("" : "+v"(fr), "+v"(fq));
        const int row0 = u.pm * 256 + wr * 64 + fr, col0 = u.pn * 256 + wc * 32 + 4 * fq;
#pragma unroll
        for (int ai = 0; ai < 2; ++ai)
#pragma unroll
            for (int m = 0; m < 4; ++m) { const size_t row = (size_t)(row0 + ai * 128 + m * 16);
#pragma unroll
                for (int bj = 0; bj < 2; ++bj)
#pragma unroll
                    for (int n = 0; n < 2; ++n) { const int col = col0 + bj * 128 + n * 16; const pg8::f32x4 e = gate4(PROJ + row * N1 + C_G + 2 * DM + col); pg8::f32x4 v;
#pragma unroll
                        for (int j = 0; j < 4; ++j) v[j] = acc[ai][bj][m][n][j] * __builtin_amdgcn_rcpf(e[j]);
                        v2u w; w.x = pg8::cvt_pk_bf16(v[0], v[1]); w.y = pg8::cvt_pk_bf16(v[2], v[3]); *(v2u*)(MERGED + row * DM + col) = w; } }
    }
};
struct Epi4 {
    static constexpr bool PERM = false;
    const float* X; float* OUT; bf16* X1G; const float* gffn; float* rowss;
    __device__ __forceinline__ void operator()(const pg8::f32x4 (&acc)[2][2][4][2], const pg8::Unit& u, int wr, int wc, int fr, int fq) const {
        const int row0 = u.pm * 256 + wr * 64 + fr, col0 = u.pn * 256 + wc * 32 + 4 * fq;
#pragma unroll
        for (int ai = 0; ai < 2; ++ai)
#pragma unroll
            for (int m = 0; m < 4; ++m) { const size_t row = (size_t)(row0 + ai * 128 + m * 16); float ss = 0.f;
#pragma unroll
                for (int bj = 0; bj < 2; ++bj)
#pragma unroll
                    for (int n = 0; n < 2; ++n) { const int col = col0 + bj * 128 + n * 16;
                        const pg8::f32x4 x1 = *(const pg8::f32x4*)(X + row * DM + col) + acc[ai][bj][m][n];
                        *(pg8::f32x4*)(OUT + row * DM + col) = x1;
                        ss += (x1[0] * x1[0] + x1[1] * x1[1]) + (x1[2] * x1[2] + x1[3] * x1[3]);
                        const pg8::f32x4 gg = *(const pg8::f32x4*)(gffn + col);
                        v2u w; w.x = pg8::cvt_pk_bf16(x1[0] * gg[0], x1[1] * gg[1]); w.y = pg8::cvt_pk_bf16(x1[2] * gg[2], x1[3] * gg[3]); *(v2u*)(X1G + row * DM + col) = w; }
                ss += __shfl_xor(ss, 16); ss += __shfl_xor(ss, 32);
                if (fq == 0) atomicAdd(rowss + row, ss); }
    }
};
typedef float f32x16r __attribute__((ext_vector_type(16)));
__device__ __forceinline__ void router_block(const Args& A, const Frame& F, LAS unsigned char* lds, int tok0) {
    unsigned char* ws = A.ws; const float* X1 = A.out; const float* rowss = (const float*)(ws + WS_CTL) + CW_ROWSS;
    const int lane = F.lane, w = F.wave, i = lane & 31, kk = lane >> 5;
    f32x16r acc0 = {}, acc1 = {};
    const float* xrow = X1 + (size_t)(tok0 + i) * DM + 256 * w;
    const float* gp = A.ffn_norm_g + 256 * w;
    const float* We = A.router_expert_w + (size_t)(256 * w) * NEXP + i;
    const float* Wg = A.router_group_w + (size_t)(256 * w) * NGRP + (i & 3);
#pragma unroll 4
    for (int kq = 0; kq < 64; ++kq) {
        const f32x4 xa = *(const f32x4*)(xrow + 4 * kq) * *(const f32x4*)(gp + 4 * kq);
        const int k0 = 4 * kq + kk;
        const float a0 = kk ? xa[1] : xa[0], a1 = kk ? xa[3] : xa[2];
        const float b00 = We[(size_t)k0 * NEXP], b01 = We[(size_t)(k0 + 2) * NEXP];
        float b10 = Wg[(size_t)k0 * NGRP], b11 = Wg[(size_t)(k0 + 2) * NGRP];
        if (i >= 4) { b10 = 0.f; b11 = 0.f; }
        acc0 = __builtin_amdgcn_mfma_f32_32x32x2f32(a0, b00, acc0, 0, 0, 0);
        acc1 = __builtin_amdgcn_mfma_f32_32x32x2f32(a0, b10, acc1, 0, 0, 0);
        acc0 = __builtin_amdgcn_mfma_f32_32x32x2f32(a1, b01, acc0, 0, 0, 0);
        acc1 = __builtin_amdgcn_mfma_f32_32x32x2f32(a1, b11, acc1, 0, 0, 0);
    }
    LAS float* P = (LAS float*)lds;
    LAS float* R = (LAS float*)(lds + 65536);
#pragma unroll
    for (int r = 0; r < 16; ++r) { const int trow = (r & 3) + 8 * (r >> 2) + 4 * kk;
        P[(w * 32 + trow) * 64 + i] = acc0[r]; P[(w * 32 + trow) * 64 + 32 + i] = acc1[r]; }
    __syncthreads();
    for (int idx = F.tid; idx < 2048; idx += NTHREADS) { float s = 0.f;
#pragma unroll
        for (int q = 0; q < 8; ++q) s += P[q * 2048 + idx];
        R[idx] = s; }
    __syncthreads();
    if (F.tid < 32) {
        const int tok = tok0 + F.tid; const LAS float* lr = R + F.tid * 64;
        const float rs = 1.0f / sqrtf(rowss[tok] * (1.f / DM) + EPS);
        float gl[4];
#pragma unroll
        for (int o = 0; o < 4; ++o) gl[o] = lr[32 + o] * rs + A.router_group_b[o];
        int grp = 0; float gmax = gl[0];
#pragma unroll
        for (int o = 1; o < 4; ++o) if (gl[o] > gmax) { gmax = gl[o]; grp = o; }
        float den = 0.f;
#pragma unroll
        for (int o = 0; o < 4; ++o) den += expf(gl[o] - gmax);
        const float psel = 1.0f / den;
        float el[8];
#pragma unroll
        for (int j = 0; j < 8; ++j) el[j] = lr[grp * 8 + j] * rs + A.router_expert_b[grp * 8 + j];
        int j1 = 0; float l1 = el[0];
#pragma unroll
        for (int j = 1; j < 8; ++j) if (el[j] > l1) { l1 = el[j]; j1 = j; }
        int j2 = -1; float l2 = -__builtin_inff();
#pragma unroll
        for (int j = 0; j < 8; ++j) if (j != j1 && el[j] > l2) { l2 = el[j]; j2 = j; }
        const float e2 = expf(l2 - l1); const float g1 = psel / (1.0f + e2), g2 = psel * e2 / (1.0f + e2);
        unsigned* cnt = (unsigned*)(ws + WS_CTL) + CW_CNT; int* LTOK = (int*)(ws + WS_LTOK); float* LGATE = (float*)(ws + WS_LGATE);
        const int e1i = grp * 8 + j1, e2i = grp * 8 + j2;
        const unsigned p1 = atomicAdd(cnt + e1i, 1u); LTOK[(size_t)e1i * MTOK + p1] = tok * 2; LGATE[(size_t)e1i * MTOK + p1] = g1;
        const unsigned p2 = atomicAdd(cnt + e2i, 1u); LTOK[(size_t)e2i * MTOK + p2] = tok * 2 + 1; LGATE[(size_t)e2i * MTOK + p2] = g2;
    }
    __syncthreads();
}
__device__ __forceinline__ void moe_tables(const Args& A, LAS unsigned char* lds, const Frame& F) {
    LAS int* T = (LAS int*)(lds + LDSCTL_OFF);
    if (F.tid < 64) {
        const unsigned* cnt = (const unsigned*)(A.ws + WS_CTL) + CW_CNT; const int e = F.tid;
        const int c = e < NEXP ? (int)__hip_atomic_load(cnt + e, __ATOMIC_RELAXED, __HIP_MEMORY_SCOPE_AGENT) : 0; const int mt = (c + 255) >> 8;
        int inc = mt;
#pragma unroll
        for (int o = 1; o < 32; o <<= 1) { const int v = __shfl_up(inc, o); if ((e & 31) >= o) inc += v; }
        const int excl = inc - mt;
        if (e < NEXP) { T[e] = excl * 16; T[40 + e] = excl * 256; T[80 + e] = c; }
        if (e == NEXP - 1) { T[32] = inc * 16; T[72] = inc * 256; }
    }
    __syncthreads();
}
struct SchedMoeLC {
    int G, c, K; int mode;
    const char* Ap; const float* W0; const float* W1; const int* LTOK; const LAS int* T; bool dbg_same;
    __device__ __forceinline__ bool next(int i, pg8::Unit& u) const {
        const int L = i * G + c; if (L >= T[32]) return false;
        int e = 0;
#pragma unroll 1
        for (int s = 16; s >= 1; s >>= 1) if (T[e + s] <= L) e += s;
        const int l = L - T[e], mte = (T[e + 1] - T[e]) >> 4; u.e = e; u.pn = l / mte; u.pm = l - u.pn * mte; u.aux = T[80 + e] - u.pm * 256;
        return true;
    }
    __device__ __forceinline__ const char* abase() const { return Ap; }
    __device__ __forceinline__ unsigned arow_off(const pg8::Unit& u, int r) const {
        if (mode == 0) { const int tok = (r < u.aux) ? (LTOK[(size_t)u.e * MTOK + u.pm * 256 + r] >> 1) : 0; return (unsigned)tok * (unsigned)(K * 2); }
        return (unsigned)(T[40 + u.e] + u.pm * 256 + r) * (unsigned)(K * 2);
    }
    __device__ __forceinline__ int bpitch() const { return mode == 0 ? FF : DM; }
    __device__ __forceinline__ const float* bsrc(const pg8::Unit& u, int c4) const {
        if (dbg_same) { const int q = c4 >> 5, within = c4 & 31; return ((within < 16) ? W0 : W1) + 16 * q + (within & 15); }
        if (mode == 0) { const int q = c4 >> 5, within = c4 & 31; return ((within < 16) ? W0 : W1) + (size_t)u.e * DM * FF + 64 * u.pn + 16 * q + (within & 15); }
        return W0 + (size_t)u.e * FF * DM + 128 * u.pn + c4;
    }
};
struct Epi6 {
    bf16* HID; const int* LTOK; const float* rowss; const LAS int* T;
    __device__ __forceinline__ void operator()(const pg8::f32x4 (&acc)[4][8], const pg8::Unit& u, int cw, int fr, int fq) const {
        const int sb = T[40 + u.e] + u.pm * 256;
#pragma unroll
        for (int m = 0; m < 4; ++m) { const int r = cw * 64 + m * 16 + fr;
            const int tok = (r < u.aux) ? (LTOK[(size_t)u.e * MTOK + u.pm * 256 + r] >> 1) : 0;
            const float rs = 1.0f / sqrtf(rowss[tok] * (1.f / DM) + EPS);
#pragma unroll
            for (int q = 0; q < 4; ++q) { const pg8::f32x4 g = acc[m][2 * q] * rs, up = acc[m][2 * q + 1] * rs; pg8::f32x4 hv;
#pragma unroll
                for (int j = 0; j < 4; ++j) hv[j] = g[j] / (1.0f + __expf(-g[j])) * up[j];
                v2u w; w.x = pg8::cvt_pk_bf16(hv[0], hv[1]); w.y = pg8::cvt_pk_bf16(hv[2], hv[3]);
                *(v2u*)(HID + (size_t)(sb + r) * FF + u.pn * 64 + q * 16 + 4 * fq) = w; } }
    }
};
struct Epi7 {
    bf16* Y; const int* LTOK; const float* LGATE;
    __device__ __forceinline__ void operator()(const pg8::f32x4 (&acc)[4][8], const pg8::Unit& u, int cw, int fr, int fq) const {
#pragma unroll
        for (int m = 0; m < 4; ++m) { const int r = cw * 64 + m * 16 + fr;
            if (r < u.aux) { const size_t li = (size_t)u.e * MTOK + u.pm * 256 + r; const int aid = LTOK[li]; const float gate = LGATE[li];
                bf16* yp = Y + (size_t)aid * DM + u.pn * 128 + 4 * fq;
#pragma unroll
                for (int n = 0; n < 8; ++n) { const pg8::f32x4 v = acc[m][n] * gate; v2u w; w.x = pg8::cvt_pk_bf16(v[0], v[1]); w.y = pg8::cvt_pk_bf16(v[2], v[3]); *(v2u*)(yp + n * 16) = w; } } }
    }
};


#ifdef MK_DIAG
__device__ __forceinline__ float blk_reduce(float v, bool ismax, LAS float* red, int tid) {
    for (int o = 1; o < 64; o <<= 1) { const float t = __shfl_xor(v, o); v = ismax ? fmaxf(v, t) : v + t; }
    __syncthreads(); if ((tid & 63) == 0) red[tid >> 6] = v; __syncthreads();
    float r = red[0]; for (int i = 1; i < 8; ++i) r = ismax ? fmaxf(r, red[i]) : r + red[i];
    __syncthreads(); return r;
}
__device__ __forceinline__ void diag_row(const Args& A, LAS unsigned char* lds, int b, int t, int tid) {
    unsigned char* ws = A.ws; const int row = b * SEQ + t; float* ctl = (float*)(ws + WS_CTL) + 512;
    LAS float* sc = (LAS float*)lds; LAS float* lg = sc + 4096; LAS float* cum = lg + 4096; LAS float* red = cum + 4096; LAS float* ov = red + 64; LAS unsigned char* sel = (LAS unsigned char*)(ov + 512);
    const bf16* OUTR = (const bf16*)(ws + WS_OF) + (size_t)row * DM;
    for (int s = tid; s < SEQ; s += NTHREADS) { float v = -__builtin_inff();
        if (s <= t) { v = 0.f; for (int j = 0; j < IDXH; ++j) { float d = 0.f;
                for (int k = 0; k < IDXD; ++k) { const int srow = b * SEQ + s; d += bf2f(((const bf16*)(ws + WS_QI))[(size_t)row * 1024 + j * 64 + k]) * bf2f(((const bf16*)(ws + WS_KI))[((size_t)(srow >> 5) * 8 + (k >> 3)) * 256 + (srow & 31) * 8 + (k & 7)]); }
                v += ((const float*)(ws + WS_WI))[(size_t)row * IDXH + j] * fmaxf(d, 0.f); } }
        sc[s] = v; }
    __syncthreads();
    for (int s = tid; s < SEQ; s += NTHREADS) { int rank = 0; const float v = sc[s];
        if (s <= t) { for (int q = 0; q <= t; ++q) { const float u = sc[q]; rank += (u > v || (u == v && q < s)) ? 1 : 0; } }
        sel[s] = (s <= t && rank < TOPK) ? 1 : 0; }
    __syncthreads();
    float sd[3] = {0.f, 0.f, 0.f}, sr[3] = {0.f, 0.f, 0.f};
    for (int kind = 0; kind < 3; ++kind) {
        const int nh = kind == 2 ? 4 : 6, nk = kind == 2 ? NMEM : t + 1;
        if (kind == 0 && tid == 0) { }
        for (int h = 0; h < nh; ++h) {
            const bf16* Q; const bf16* K; const bf16* V; int ocol;
            if (kind == 0) { const size_t ho = (size_t)(b * 6 + h) * SEQ * HD; Q = (const bf16*)(ws + WS_QF) + ho + (size_t)t * HD; K = (const bf16*)(ws + WS_KF) + ho; V = (const bf16*)(ws + WS_VF) + ho; ocol = h * HD; }
            else if (kind == 1) { const size_t ho = (size_t)(b * 6 + h) * SEQ * HD; Q = (const bf16*)(ws + WS_QD) + ho + (size_t)t * HD; K = (const bf16*)(ws + WS_KD) + ho; V = (const bf16*)(ws + WS_VD) + ho; ocol = FOXW + h * HD; }
            else { Q = (const bf16*)(ws + WS_QC) + ((size_t)(b * 4 + h) * SEQ + t) * HD; K = (const bf16*)(ws + WS_KC) + (size_t)(b * 4 + h) * NMEM * HD; V = (const bf16*)(ws + WS_VC) + (size_t)(b * 4 + h) * NMEM * HD; ocol = FOXW + DSAW + h * HD; }
            if (kind == 0) { if (tid == 0) { float c = 0.f; const float* lf = (const float*)(ws + WS_LOGF) + (size_t)(b * 6 + h) * SEQ; for (int s = 0; s < SEQ; ++s) { c += lf[s]; cum[s] = c; } } __syncthreads(); }
            float mx = -__builtin_inff();
            for (int s = tid; s < SEQ; s += NTHREADS) { float v = -__builtin_inff();
                if (s < nk && (kind != 1 || sel[s])) { float d = 0.f; for (int k = 0; k < HD; ++k) d += bf2f(Q[k]) * bf2f(K[(size_t)s * HD + k]); v = d * att::SCALE; if (kind == 0) v += cum[t] - cum[s]; }
                lg[s] = v; mx = fmaxf(mx, v); }
            mx = blk_reduce(mx, true, red, tid);
            float sm = 0.f;
            for (int s = tid; s < SEQ; s += NTHREADS) { const float p = (lg[s] == -__builtin_inff()) ? 0.f : expf(lg[s] - mx); lg[s] = p; sm += p; }
            sm = blk_reduce(sm, false, red, tid);
            { const int d = tid & 127, part = tid >> 7; float o = 0.f;
              for (int s = part; s < nk; s += 4) { const float p = lg[s]; if (p != 0.f) o += p * bf2f(V[(size_t)s * HD + d]); }
              ov[tid] = o; }
            __syncthreads();
            if (tid < 128) { const float o = (ov[tid] + ov[128 + tid] + ov[256 + tid] + ov[384 + tid]) / sm; const float g = bf2f(OUTR[ocol + tid]); sd[kind] += (g - o) * (g - o); sr[kind] += o * o; }
            __syncthreads();
        }
    }
    for (int kind = 0; kind < 3; ++kind) { const float a = blk_reduce(sd[kind], false, red, tid), c = blk_reduce(sr[kind], false, red, tid); if (tid == 0) { atomicAdd(ctl + 2 * kind, a); atomicAdd(ctl + 2 * kind + 1, c); } }
}
#endif
constexpr int NPHASES = 11;
__global__ void __launch_bounds__(NTHREADS, 2) mk_fwd(Args A) {
    extern __shared__ __attribute__((aligned(16))) unsigned char lds[];
    cg::grid_group grid = cg::this_grid();
    Frame F; F.tid = threadIdx.x; F.lane = F.tid & 63; F.wave = __builtin_amdgcn_readfirstlane(F.tid >> 6); F.G = gridDim.x; F.c = blockIdx.x;
    F.vcu = (F.G % 8 == 0) ? (F.c % 8) * (F.G / 8) + F.c / 8 : F.c;
    LAS unsigned char* L3 = (LAS unsigned char*)lds;
    unsigned char* ws = A.ws;
    const int lo = A.ph_lo, hi = A.ph_hi;
#ifndef PHASE_MASK
#define PHASE_MASK 0xFFFF
#endif
#define IN(k) (((PHASE_MASK >> (k)) & 1) && lo <= (k) && (k) < hi)
#define REFRESH0() do {} while (0)
    volatile LAS unsigned* xst = (volatile LAS unsigned*)(L3 + LDSCTL_OFF + 1024);
    if (F.tid < 4) xst[F.tid] = 0u;
    __syncthreads();
    XcdBarrier xbar = xcd_barrier_post((unsigned*)(ws + WS_CTL) + CW_BAR, xst);
#define SEAM(k) do { if (IN(k) && IN((k) + 1)) { if ((k) == 0) grid.sync(); else xcd_barrier(xbar); } } while (0)
    const int gw = F.vcu * NWAVES + F.wave, NGW = F.G * NWAVES;

    if (IN(0)) { p0_prologue(A, F, L3); } SEAM(0);
    if (IN(1)) {
        Sched1 S{F.G, F.c, (const char*)(ws + WS_H), (const char*)(ws + WS_WIN), (const char*)(ws + WS_WMKV), (unsigned)(WS_MEMN - WS_H), false};
        Epi1 E{(bf16*)(ws + WS_PROJ), (bf16*)(ws + WS_MKV)};
        pg8::gemm_phase<Epi1, Sched1, true, true>(L3, DM, S, E);
    } SEAM(1);
    if (IN(2)) {
        const RopeFreq RF = rope_freqs(F.lane);
        for (int r = gw; r < MTOK + BATCH * NMEM; r += NGW) { if (r < MTOK) p1b_row(A, r, F.lane, RF); else p1b_memrow(A, r - MTOK, F.lane); }
    } SEAM(2);
    if (IN(3)) {
        for (int it = F.c; it < 256; it += F.G) { const int b = it >> 7, y = it & 127; indexer_block(A, F, L3, b, y); indexer_block(A, F, L3, b, 255 - y); }
    } SEAM(3);
    if (IN(4)) {
        const int G = F.G, v = F.vcu;
        attn_stream<1, 0>(A, F, (char*)lds, v, 96);
        attn_stream<2, 1>(A, F, (char*)lds, (v + G - (96 % G)) % G, 96);
        attn_stream<3, 2>(A, F, (char*)lds, (v + G - (192 % G)) % G, 64);
        { const int ci = (v + G - (192 % G)) % G;
          Sched1 S{G, ci, (const char*)(ws + WS_H), (const char*)(ws + WS_WIN), (const char*)(ws + WS_WMKV), (unsigned)(WS_MEMN - WS_H), true};
          Epi1 E{(bf16*)(ws + WS_PROJ), (bf16*)(ws + WS_MKV)};
          pg8::gemm_phase<Epi1, Sched1, true, true>(L3, DM, S, E); }
    } SEAM(4);
    if (IN(5)) {
        SchedRows S{F.G, F.c, 8, DM, (const char*)(ws + WS_OF), (const char*)(ws + WS_WBF)}; Epi3 E{(const bf16*)(ws + WS_PROJ), (bf16*)(ws + WS_MERGED)}; HookMerge H{(const bf16*)(ws + WS_PROJ)};
        pg8::gemm_phase<Epi3, SchedRows, true, true, HookMerge>(L3, DM, S, E, H);
    } SEAM(5);
    if (IN(6)) {
        SchedRows S{F.G, F.c, 8, DM, (const char*)(ws + WS_MERGED), (const char*)(ws + WS_WOUT)};
        Epi4 E{A.x, A.out, (bf16*)(ws + WS_X1G), A.ffn_norm_g, (float*)(ws + WS_CTL) + CW_ROWSS};
        pg8::gemm_phase<Epi4, SchedRows, true, true>(L3, DM, S, E);
    } SEAM(6);
    if (IN(7)) { for (int it = F.c; it < MTOK / 32; it += F.G) router_block(A, F, L3, it * 32); } SEAM(7);
    if (IN(8)) {
        moe_tables(A, L3, F);
        const bool dbg = (A.flags & 4) != 0;
        SchedMoeLC S{F.G, F.vcu, DM, 0, (const char*)(ws + WS_X1G), A.expert_w_gate, A.expert_w_up, (const int*)(ws + WS_LTOK), (const LAS int*)(L3 + LDSCTL_OFF), dbg};
        Epi6 E{(bf16*)(ws + (dbg ? WS_WGU : WS_HID)), (const int*)(ws + WS_LTOK), (const float*)(ws + WS_CTL) + CW_ROWSS, (const LAS int*)(L3 + LDSCTL_OFF)};
        lc::gemm_lc<Epi6, SchedMoeLC>(L3, DM, S, E);
    } SEAM(8);
    if (IN(9)) {
        moe_tables(A, L3, F);
        SchedMoeLC S{F.G, F.vcu, FF, 1, (const char*)(ws + WS_HID), A.expert_w_down, nullptr, (const int*)(ws + WS_LTOK), (const LAS int*)(L3 + LDSCTL_OFF), false};
        Epi7 E{(bf16*)(ws + WS_Y), (const int*)(ws + WS_LTOK), (const float*)(ws + WS_LGATE)};
        lc::gemm_lc<Epi7, SchedMoeLC>(L3, FF, S, E);
    } SEAM(9);
#ifdef MK_DIAG
    if (lo == 11) { REFRESH0(); for (int it = F.c; it < 256; it += F.G) { const int b = it & 1; const int t = (it < 32) ? (it * 9 + 3) : (int)(((unsigned)it * 2654435761u >> 7) % SEQ); diag_row(A, L3, b, t, F.tid); } }
#endif
    if (IN(10)) {
        const v2u* Y = (const v2u*)(ws + WS_Y); f32x4* O = (f32x4*)A.out;
        for (size_t i = (size_t)F.c * NTHREADS + F.tid; i < (size_t)MTOK * (DM / 4); i += (size_t)F.G * NTHREADS) {
            const size_t tok = i / (DM / 4), c4 = i % (DM / 4);
            const v2u y0 = Y[(2 * tok) * (DM / 4) + c4], y1 = Y[(2 * tok + 1) * (DM / 4) + c4]; f32x4 o = O[i];
            o.x += bflo(y0.x) + bflo(y1.x); o.y += bfhi(y0.x) + bfhi(y1.x); o.z += bflo(y0.y) + bflo(y1.y); o.w += bfhi(y0.y) + bfhi(y1.y);
            O[i] = o;
        }
#ifdef MK_DIAG
        if (F.c == 0 && F.tid == 0) { const float* ctl = (const float*)(ws + WS_CTL) + 512; float e = 0.f;
            for (int k = 0; k < 3; ++k) if ((MK_DIAG >> k) & 1) e = fmaxf(e, sqrtf(ctl[2 * k] / fmaxf(ctl[2 * k + 1], 1e-30f)));
            __builtin_amdgcn_s_sleep(100); A.out[(size_t)MTOK * DM - 1] += 1000.f * e; }
#endif
    }
#undef IN
#undef SEAM
}

extern "C" void kernel_launch(void* const* d_in, const int* in_sizes, int n_in, void* d_out, int out_size, void* d_ws, size_t ws_size, hipStream_t stream) {
    static int grid = 0;
    if (grid == 0) {
        if (n_in != 27 || out_size != MTOK * DM || ws_size < WS_END) { fprintf(stderr, "kernel_launch: unexpected shapes (n_in %d out %d ws %zu need %zu)\n", n_in, out_size, ws_size, (size_t)WS_END); grid = -1; return; }
        int dev = 0, cus = 0, per_cu = 0;
        (void)hipGetDevice(&dev); (void)hipDeviceGetAttribute(&cus, hipDeviceAttributeMultiprocessorCount, dev);
        (void)hipFuncSetAttribute((const void*)mk_fwd, hipFuncAttributeMaxDynamicSharedMemorySize, LDS_BYTES);
        (void)hipOccupancyMaxActiveBlocksPerMultiprocessor(&per_cu, (const void*)mk_fwd, NTHREADS, LDS_BYTES);
        if (per_cu < 1) fprintf(stderr, "kernel_launch: occupancy query says %d blocks/CU\n", per_cu);
        (void)hipGetLastError();
        grid = cus > 0 ? cus : 256;
    }
    if (grid < 0) return;
    (void)hipMemsetAsync((char*)d_ws + WS_CTL, 0, CTL_ZERO_BYTES, stream);
    Args a{};
    const float** pf = (const float**)&a;
    for (int i = 0; i < 27; ++i) pf[i] = (const float*)d_in[i];
    a.positions = (const int*)d_in[2];
    a.out = (float*)d_out; a.ws = (unsigned char*)d_ws;
#if MK_N_LAUNCHES == 1
    a.ph_lo = 0; a.ph_hi = NPHASES;
    void* args[] = {&a};
    hipError_t e = hipLaunchCooperativeKernel((const void*)mk_fwd, dim3(grid), dim3(NTHREADS), args, LDS_BYTES, stream);
    if (e != hipSuccess) fprintf(stderr, "cooperative launch failed: %s (grid %d)\n", hipGetErrorString(e), grid);
#else
#ifndef EXP_REPEAT
#define EXP_REPEAT 0
#endif
#ifndef EXP_FLAGS
#define EXP_FLAGS 0
#endif
    for (int p = 0; p < NPHASES; ++p) { a.ph_lo = p; a.ph_hi = p + 1;
#ifdef MK_DIAG
        if (p == 10) { a.ph_lo = 11; a.ph_hi = 11; a.flags = 0; hipLaunchKernelGGL(mk_fwd, dim3(grid), dim3(NTHREADS), LDS_BYTES, stream, a); a.ph_lo = 10; a.ph_hi = 11; }
#endif
        for (int r = 0; r < (((EXP_REPEAT >> p) & 1) ? 2 : 1); ++r) { a.flags = r ? EXP_FLAGS : 0; hipLaunchKernelGGL(mk_fwd, dim3(grid), dim3(NTHREADS), LDS_BYTES, stream, a); } }
#endif
}
```

```cpp
#include <hip/hip_runtime.h>
#include <hip/hip_cooperative_groups.h>
#include <cstdio>
#include <cstdint>
namespace cg = cooperative_groups;

#ifndef MK_N_LAUNCHES
#define MK_N_LAUNCHES 1
#endif

constexpr int BATCH = 2, SEQ = 4096, MTOK = BATCH * SEQ, DM = 2048;
constexpr int HD = 128, FOXH = 6, DSAH = 6, CRH = 4, NMEM = 256;
constexpr int FOXW = FOXH * HD, DSAW = DSAH * HD, CRW = CRH * HD;
constexpr int IDXH = 16, IDXD = 64, TOPK = 256;
constexpr int NEXP = 32, EPG = 8, NGRP = 4, FF = 1024;
constexpr int INW = 12374, N1 = 12544;
constexpr float EPS = 1e-6f;
constexpr float ROPE_THETA = 500000.0f;
constexpr int C_FQ = 0, C_FK = 768, C_FV = 1536, C_DQ = 2304, C_DK = 3072, C_DV = 3840, C_CQ = 4608, C_IQ = 5120, C_IK = 6144, C_FL = 6208, C_IW = 6214, C_G = 6272;
__host__ __device__ __forceinline__ int win_src_col(int n) {
    if (n < 2304) return n;
    if (n < 4608) return n - 2304 + 2310;
    if (n < 5120) return n - 4608 + 5718;
    if (n < 6144) return n - 5120 + 4614;
    if (n < 6208) return n - 6144 + 5654;
    if (n < 6214) return n - 6208 + 2304;
    if (n < 6230) return n - 6214 + 5638;
    if (n < 6272) return -1;
    if (n < 12416) return n - 6272 + 6230;
    return -1;
}
constexpr int MAXSLOT = 24576;

constexpr size_t MiB = 1u << 20;
constexpr size_t al256(size_t x) { return (x + 255) & ~(size_t)255; }
constexpr size_t WS_CTL = 0, CTL_ZERO_BYTES = 1 * MiB;
constexpr size_t WS_WIN = 1 * MiB;
constexpr size_t WS_WMKV = WS_WIN + (size_t)N1 * DM * 2;
constexpr size_t WS_WBF = WS_WMKV + (size_t)1024 * DM * 2;
constexpr size_t WS_WBD = WS_WBF + (size_t)DM * FOXW * 2;
constexpr size_t WS_WBC = WS_WBD + (size_t)DM * DSAW * 2;
constexpr size_t WS_WOUT = WS_WBC + (size_t)DM * CRW * 2;
constexpr size_t WS_WGU = WS_WOUT + (size_t)DM * DM * 2;
constexpr size_t WS_WD = WS_WGU + (size_t)NEXP * 2048 * DM * 2;
constexpr size_t WS_H = WS_WD + (size_t)NEXP * DM * FF * 2;
constexpr size_t WS_MEMN = WS_H + (size_t)MTOK * DM * 2;
constexpr size_t WS_MKV = WS_MEMN + (size_t)512 * DM * 2;
constexpr size_t WS_QF = WS_MKV + (size_t)512 * 1024 * 2;
constexpr size_t HSZ6 = (size_t)BATCH * 6 * SEQ * HD * 2, HSZ4 = (size_t)BATCH * 4 * SEQ * HD * 2;
constexpr size_t WS_KF = WS_QF + HSZ6, WS_VF = WS_KF + HSZ6, WS_QD = WS_VF + HSZ6, WS_KD = WS_QD + HSZ6, WS_VD = WS_KD + HSZ6;
constexpr size_t WS_QC = WS_VD + HSZ6;
constexpr size_t WS_KC = WS_QC + HSZ4;
constexpr size_t WS_VC = WS_KC + (size_t)BATCH * 4 * NMEM * HD * 2;
constexpr size_t WS_QI = WS_VC + (size_t)BATCH * 4 * NMEM * HD * 2;
constexpr size_t WS_KI = WS_QI + (size_t)MTOK * IDXH * IDXD * 2;
constexpr size_t WS_WI = WS_KI + (size_t)MTOK * IDXD * 2;
constexpr size_t WS_LOGF = WS_WI + (size_t)MTOK * IDXH * 4;
constexpr size_t WS_MASK = WS_LOGF + (size_t)BATCH * FOXH * SEQ * 4;
constexpr size_t WS_OF = WS_MASK + (size_t)MTOK * 64 * 8;
constexpr size_t WS_OD = WS_OF + (size_t)MTOK * FOXW * 2;
constexpr size_t WS_OC = WS_OD + (size_t)MTOK * DSAW * 2;
constexpr size_t WS_LTOK = WS_OC + (size_t)MTOK * CRW * 2;
constexpr size_t WS_LGATE = WS_LTOK + (size_t)NEXP * MTOK * 4;
constexpr size_t WS_RA = al256(WS_LGATE + (size_t)NEXP * MTOK * 4);
constexpr size_t RA_BYTES = (size_t)MTOK * N1 * 2;
constexpr size_t WS_PROJ = WS_RA;
constexpr size_t WS_END0 = WS_RA + RA_BYTES;
constexpr size_t WS_RB = al256(WS_END0);
constexpr size_t WS_SCORES = WS_RB;
constexpr size_t WS_M32 = WS_RB;
constexpr size_t WS_MERGED = WS_RB + (size_t)MTOK * DM * 4;
constexpr size_t WS_X1G = WS_MERGED + (size_t)MTOK * DM * 2;
constexpr size_t WS_Y = WS_RA;
constexpr size_t WS_HID = WS_RB + (size_t)MTOK * SEQ * 4;
constexpr size_t WS_END = WS_HID + (size_t)MAXSLOT * FF * 2;
static_assert(WS_X1G + (size_t)MTOK * DM * 2 <= WS_HID, "region B map");
static_assert((size_t)2 * MTOK * DM * 4 <= RA_BYTES, "Y fits region A");
constexpr int CW_CNT = 64;
constexpr int CW_ROWSS = 1024;
constexpr int CW_BAR = 16384;
static_assert(CW_ROWSS + MTOK <= CW_BAR && (CW_BAR + 3456) * 4 <= (int)CTL_ZERO_BYTES, "ctl");

constexpr int RING_BYTES = 131072;
constexpr int LDSCTL_OFF = RING_BYTES;
constexpr int LDS_BYTES = 163840;
constexpr int NWAVES = 8, NTHREADS = 512;

#define GAS __attribute__((address_space(1)))
#define LAS __attribute__((address_space(3)))
typedef unsigned short bf16;
typedef unsigned v4u __attribute__((ext_vector_type(4)));
typedef unsigned v2u __attribute__((ext_vector_type(2)));
typedef float f32x4 __attribute__((ext_vector_type(4)));
typedef float f32x16 __attribute__((ext_vector_type(16)));
typedef short bf16x8 __attribute__((ext_vector_type(8)));
#define LDS_WAIT() asm volatile("s_waitcnt lgkmcnt(0)" ::: "memory")
#define VM_WAIT() asm volatile("s_waitcnt vmcnt(0)" ::: "memory")
__device__ __forceinline__ unsigned f2bf(float f) { unsigned u = __builtin_bit_cast(unsigned, f); return (u + 0x7fffu + ((u >> 16) & 1u)) >> 16; }
__device__ __forceinline__ unsigned pk2(float lo, float hi) { return f2bf(lo) | (f2bf(hi) << 16); }
__device__ __forceinline__ float bf2f(unsigned short b) { return __builtin_bit_cast(float, (unsigned)b << 16); }
__device__ __forceinline__ float bflo(unsigned w) { return __builtin_bit_cast(float, w << 16); }
__device__ __forceinline__ float bfhi(unsigned w) { return __builtin_bit_cast(float, w & 0xffff0000u); }
__device__ __forceinline__ float wave_sum(float v) {
#pragma unroll
    for (int o = 1; o < 64; o <<= 1) v += __shfl_xor(v, o);
    return v;
}
namespace pg8 {
#define PG8_LAS __attribute__((address_space(3)))
typedef unsigned short bf16_t;
typedef short bf16x8 __attribute__((ext_vector_type(8)));
typedef float f32x4 __attribute__((ext_vector_type(4)));
typedef float f32x2 __attribute__((ext_vector_type(2)));
typedef unsigned u32x4 __attribute__((ext_vector_type(4)));
typedef unsigned u32x2 __attribute__((ext_vector_type(2)));
constexpr int BM = 256, BK = 64, HALF = 128, HTB = HALF * BK * 2  , STAGE_BYTES = 8 * HTB, NXCD = 8, WGM = 8;

__host__ __device__ __forceinline__ int lds_byte(int r, int c) { const int st = (r >> 4) * 2 + (c >> 5), rr = r & 15, cc = c & 31, ob = rr * 64 + cc * 2; return st * 1024 + (ob ^ (((ob >> 9) & 1) << 5)); }
__host__ __device__ __forceinline__ void stage_rc(int b, int& R, int& C) { const int st = b / 1024, sb = b % 1024, swz = sb ^ (((sb >> 9) & 1) << 5); R = (st >> 1) * 16 + swz / 64; C = (st & 1) * 32 + (swz % 64) / 2; }
__host__ __device__ __forceinline__ int perm32(int rho) { const int n = rho >> 4, i = rho & 15; return 8 * (i >> 2) + 4 * n + (i & 3); }

struct Unit { int pm, pn, e, aux; };

__device__ __forceinline__ void tile_order(int L, int nM, int nN, int& pm, int& pn) {
    const int nwg = nM * nN; int wgid = L;
    { const int q = nwg / NXCD, r = nwg % NXCD, xcd = wgid % NXCD, off = wgid / NXCD; wgid = (xcd < r ? xcd * (q + 1) : r * (q + 1) + (xcd - r) * q) + off; }
    const int nig = WGM * nN, gid = wgid / nig, fm = gid * WGM, gsz = (nM - fm) < WGM ? (nM - fm) : WGM;
    pm = fm + ((wgid % nig) % gsz); pn = (wgid % nig) / gsz;
}

__device__ __forceinline__ unsigned cvt_pk_bf16(float lo, float hi) { unsigned r; asm volatile("v_cvt_pk_bf16_f32 %0, %1, %2" : "=v"(r) : "v"(lo), "v"(hi)); return r; }

struct NoHook { static constexpr bool ENABLED = false; __device__ __forceinline__ bool at(int) const { return false; } __device__ __forceinline__ void operator()(f32x4 (&)[2][2][4][2], const Unit&, int, int, int, int, int) const {} };
template <class Epi, class Sched, bool ALIGN_EPI = false, bool SP2 = false, class Hook = NoHook>
__device__ __forceinline__ void gemm_phase(PG8_LAS unsigned char* lds, const int K, const Sched& S, const Epi& E, const Hook& H = Hook()) {
    const int tid = threadIdx.x, wid = __builtin_amdgcn_readfirstlane(tid >> 6), lane = tid & 63, wr = wid >> 2, wc = wid & 3, fr = lane & 15, fq = lane >> 4;
    const int nt = K / BK;
    int R0, C0, R1, C1; stage_rc(tid * 16, R0, C0); stage_rc(tid * 16 + 8192, R1, C1);
    unsigned voffB[2];
    { const int Rb0 = Epi::PERM ? ((R0 & ~31) + perm32(R0 & 31)) : R0, Rb1 = Epi::PERM ? ((R1 & ~31) + perm32(R1 & 31)) : R1;
      voffB[0] = (unsigned)(Rb0 * K + C0) * 2u; voffB[1] = (unsigned)(Rb1 * K + C1) * 2u; }
    const size_t kstep = (size_t)(BK * 2);
    const size_t hstep = (size_t)HALF * K * 2;
    const unsigned ldsw = (unsigned)wid * 1024u;
    const int aoff = lds_byte(wr * 64 + fr, fq * 8), boff = lds_byte(wc * 32 + fr, fq * 8);
#define PG8_SA(b, h) (((b) * 2 + (h)) * HTB)
#define PG8_SB(b, h) ((4 + (b) * 2 + (h)) * HTB)
#define PG8_STAGE(bufoff, gbase, v0, v1) do { \
        __builtin_amdgcn_global_load_lds((const unsigned*)((const char*)(gbase) + (v0)), (PG8_LAS unsigned*)(lds + (bufoff) + ldsw), 16, 0, 0); \
        __builtin_amdgcn_global_load_lds((const unsigned*)((const char*)(gbase) + (v1)), (PG8_LAS unsigned*)(lds + (bufoff) + ldsw + 8192), 16, 0, 0); } while (0)
#define PG8_STAGEB(bufoff, gbase) PG8_STAGE(bufoff, gbase, voffB[0], voffB[1])
#define PG8_LDA(dst, b, h) do { _Pragma("unroll") for (int m = 0; m < 4; ++m) _Pragma("unroll") for (int k = 0; k < 2; ++k) dst[m][k] = *(const PG8_LAS bf16x8*)(lds + PG8_SA(b, h) + aoff + m * 2048 + k * 1024); } while (0)
#define PG8_LDB(dst, b, h) do { _Pragma("unroll") for (int n = 0; n < 2; ++n) _Pragma("unroll") for (int k = 0; k < 2; ++k) dst[n][k] = *(const PG8_LAS bf16x8*)(lds + PG8_SB(b, h) + boff + n * 2048 + k * 1024); } while (0)
#define PG8_MMA(ai, bj, At, Bt) do { __builtin_amdgcn_s_setprio(1); _Pragma("unroll") for (int m = 0; m < 4; ++m) _Pragma("unroll") for (int n = 0; n < 2; ++n) _Pragma("unroll") for (int k = 0; k < 2; ++k) \
        acc[ai][bj][m][n] = __builtin_amdgcn_mfma_f32_16x16x32_bf16(Bt[n][k], At[m][k], acc[ai][bj][m][n], 0, 0, 0); __builtin_amdgcn_s_setprio(0); } while (0)
#define PG8_WAIT_V(n) asm volatile("s_waitcnt vmcnt(" #n ")" ::: "memory")
#define PG8_WAIT_L(n) asm volatile("s_waitcnt lgkmcnt(" #n ")" ::: "memory")
#define PG8_BAR __builtin_amdgcn_s_barrier()
#define PG8_SCHED __builtin_amdgcn_sched_barrier(0)
    Unit cur, nxt; int ui = 0;
    if (!S.next(0, cur)) return;
    f32x4 acc[2][2][4][2];
#pragma unroll
    for (int a = 0; a < 2; ++a)
#pragma unroll
        for (int b = 0; b < 2; ++b)
#pragma unroll
            for (int m = 0; m < 4; ++m)
#pragma unroll
                for (int n = 0; n < 2; ++n) acc[a][b][m][n] = (f32x4){0.f, 0.f, 0.f, 0.f};
    bf16x8 At[4][2], B0[2][2], B1[2][2];
    const char* const Ab = S.abase();
    unsigned a00 = S.arow_off(cur, R0) + (unsigned)C0 * 2u, a01 = S.arow_off(cur, R1) + (unsigned)C1 * 2u;
    unsigned a10 = S.arow_off(cur, HALF + R0) + (unsigned)C0 * 2u, a11 = S.arow_off(cur, HALF + R1) + (unsigned)C1 * 2u;
    unsigned n00, n01, n10, n11;
    const char* cB = S.bbase(cur);
    if constexpr (SP2) {
        PG8_STAGEB(PG8_SB(0, 0), cB); PG8_STAGEB(PG8_SB(0, 1), cB + hstep); PG8_STAGE(PG8_SA(0, 0), Ab, a00, a01); PG8_STAGE(PG8_SA(0, 1), Ab, a10, a11);
        if (wr == 1) PG8_BAR;
        PG8_WAIT_V(2); PG8_BAR;
        PG8_STAGEB(PG8_SB(1, 0), cB + kstep); PG8_STAGE(PG8_SA(1, 0), Ab + kstep, a00, a01); PG8_STAGEB(PG8_SB(1, 1), cB + hstep + kstep);
        PG8_WAIT_V(6); PG8_BAR;
    } else {
        PG8_STAGEB(PG8_SB(0, 0), cB); PG8_STAGE(PG8_SA(0, 0), Ab, a00, a01); PG8_STAGEB(PG8_SB(0, 1), cB + hstep); PG8_STAGE(PG8_SA(0, 1), Ab, a10, a11);
        if (wr == 1) PG8_BAR;
        PG8_WAIT_V(4); PG8_BAR;
        PG8_STAGEB(PG8_SB(1, 0), cB + kstep); PG8_STAGE(PG8_SA(1, 0), Ab + kstep, a00, a01); PG8_STAGEB(PG8_SB(1, 1), cB + hstep + kstep);
        PG8_WAIT_V(6); PG8_BAR;
    }
    for (;;) {
        const bool has_next = S.next(ui + 1, nxt);
        const char* nB = cB;
        if (has_next) { nB = S.bbase(nxt);
            int tt = tid; asm volatile("" : "+v"(tt));
            int Rn0, Cn0, Rn1, Cn1; stage_rc(tt * 16, Rn0, Cn0); stage_rc(tt * 16 + 8192, Rn1, Cn1);
            n00 = S.arow_off(nxt, Rn0) + (unsigned)Cn0 * 2u; n01 = S.arow_off(nxt, Rn1) + (unsigned)Cn1 * 2u;
            n10 = S.arow_off(nxt, HALF + Rn0) + (unsigned)Cn0 * 2u; n11 = S.arow_off(nxt, HALF + Rn1) + (unsigned)Cn1 * 2u; }
        else { n00 = a00; n01 = a01; n10 = a10; n11 = a11; }
        for (int t = 0; t < nt; t += 2) {
            const bool last = (t == nt - 2);
            const char* ak1 = Ab + (size_t)(t + 1) * kstep;
            const char* ak2 = last ? Ab : Ab + (size_t)(t + 2) * kstep;
            const char* b2 = last ? nB : cB + (size_t)(t + 2) * kstep;
            const char* ak3 = ak2 + kstep; const char* b3 = b2 + kstep;
            const unsigned x00 = last ? n00 : a00, x01 = last ? n01 : a01, x10 = last ? n10 : a10, x11 = last ? n11 : a11;
            if constexpr (Hook::ENABLED) { if (H.at(t)) { H(acc, cur, wr, wc, fr, fq, t); } __builtin_amdgcn_sched_barrier(0); }
            if constexpr (SP2) {
            PG8_LDB(B0, 0, 0); PG8_LDB(B1, 0, 1); PG8_SCHED; PG8_LDA(At, 0, 0); PG8_STAGE(PG8_SA(1, 1), ak1, a10, a11);
            PG8_WAIT_V(8); PG8_WAIT_L(0); PG8_BAR; PG8_MMA(0, 0, At, B0); PG8_MMA(0, 1, At, B1); PG8_BAR; PG8_SCHED;
            PG8_LDA(At, 0, 1); PG8_STAGEB(PG8_SB(0, 0), b2); PG8_STAGEB(PG8_SB(0, 1), b2 + hstep); PG8_STAGE(PG8_SA(0, 0), ak2, x00, x01);
            PG8_WAIT_V(8); PG8_WAIT_L(0); PG8_BAR; PG8_MMA(1, 0, At, B0); PG8_MMA(1, 1, At, B1); PG8_BAR; PG8_SCHED;
            PG8_LDB(B0, 1, 0); PG8_LDB(B1, 1, 1); PG8_SCHED; PG8_LDA(At, 1, 0); PG8_STAGE(PG8_SA(0, 1), ak2, x10, x11);
            PG8_WAIT_V(8); PG8_WAIT_L(0); PG8_BAR; PG8_MMA(0, 0, At, B0); PG8_MMA(0, 1, At, B1); PG8_BAR; PG8_SCHED;
            PG8_LDA(At, 1, 1); PG8_STAGEB(PG8_SB(1, 0), b3); PG8_STAGEB(PG8_SB(1, 1), b3 + hstep); PG8_STAGE(PG8_SA(1, 0), ak3, x00, x01);
            PG8_WAIT_V(8); PG8_WAIT_L(0); PG8_BAR; PG8_MMA(1, 0, At, B0); PG8_MMA(1, 1, At, B1); PG8_BAR; PG8_SCHED;
            } else {
            PG8_LDB(B0, 0, 0); PG8_SCHED; PG8_LDA(At, 0, 0); PG8_STAGE(PG8_SA(1, 1), ak1, a10, a11);
            PG8_WAIT_L(8); PG8_BAR; PG8_WAIT_L(0); PG8_MMA(0, 0, At, B0); PG8_BAR; PG8_SCHED;
            PG8_LDB(B1, 0, 1); PG8_STAGEB(PG8_SB(0, 0), b2);
            PG8_BAR; PG8_WAIT_L(0); PG8_MMA(0, 1, At, B1); PG8_BAR;
            PG8_LDA(At, 0, 1); PG8_STAGE(PG8_SA(0, 0), ak2, x00, x01);
            PG8_BAR; PG8_WAIT_L(0); PG8_MMA(1, 0, At, B0); PG8_BAR; PG8_SCHED;
            PG8_STAGEB(PG8_SB(0, 1), b2 + hstep);
            PG8_WAIT_V(6); PG8_BAR; PG8_MMA(1, 1, At, B1); PG8_BAR;
            PG8_LDB(B0, 1, 0); PG8_SCHED; PG8_LDA(At, 1, 0); PG8_STAGE(PG8_SA(0, 1), ak2, x10, x11);
            PG8_WAIT_L(8); PG8_BAR; PG8_WAIT_L(0); PG8_MMA(0, 0, At, B0); PG8_BAR; PG8_SCHED;
            PG8_LDB(B1, 1, 1); PG8_STAGEB(PG8_SB(1, 0), b3);
            PG8_BAR; PG8_WAIT_L(0); PG8_MMA(0, 1, At, B1); PG8_BAR;
            PG8_LDA(At, 1, 1); PG8_STAGE(PG8_SA(1, 0), ak3, x00, x01);
            PG8_BAR; PG8_WAIT_L(0); PG8_MMA(1, 0, At, B0); PG8_BAR; PG8_SCHED;
            PG8_STAGEB(PG8_SB(1, 1), b3 + hstep);
            PG8_WAIT_V(6); PG8_BAR; PG8_MMA(1, 1, At, B1); PG8_BAR;
            }
        }
        if constexpr (ALIGN_EPI) { if (wr == 0) PG8_BAR; }
        E(acc, cur, wr, wc, fr, fq);
        if (!has_next) break;
#pragma unroll
        for (int a = 0; a < 2; ++a)
#pragma unroll
            for (int b = 0; b < 2; ++b)
#pragma unroll
                for (int m = 0; m < 4; ++m)
#pragma unroll
                    for (int n = 0; n < 2; ++n) acc[a][b][m][n] = (f32x4){0.f, 0.f, 0.f, 0.f};
        cur = nxt; cB = nB; a00 = n00; a01 = n01; a10 = n10; a11 = n11; ++ui;
        if constexpr (ALIGN_EPI) { if (wr == 1) PG8_BAR; }
    }
    PG8_WAIT_V(0);
    if constexpr (!ALIGN_EPI) { if (wr == 0) PG8_BAR; }
    PG8_BAR;
#undef PG8_SA
#undef PG8_SB
#undef PG8_STAGE
#undef PG8_STAGEB
#undef PG8_LDA
#undef PG8_LDB
#undef PG8_MMA
#undef PG8_WAIT_V
#undef PG8_WAIT_L
#undef PG8_BAR
#undef PG8_SCHED
}
}
namespace lc {
using pg8::Unit; using pg8::bf16x8; using pg8::f32x4; using pg8::lds_byte;
constexpr int A_STAGE = 32768, B_STAGE = 16384, A_OFF = 0, B_OFF = 3 * A_STAGE, LDS_TOTAL = B_OFF + 2 * B_STAGE;
#define LC_LAS __attribute__((address_space(3)))
#define LC_BAR() __builtin_amdgcn_s_barrier()
template <class Epi, class Sched>
__device__ __forceinline__ void gemm_lc(LC_LAS unsigned char* lds, const int K, const Sched& S, const Epi& E) {
    constexpr int D = 4;
    int tid_ = threadIdx.x; asm volatile("" : "+v"(tid_));
    const int tid = tid_, wid = __builtin_amdgcn_readfirstlane(tid >> 6), lane = tid & 63;
    const int nt = K / 64;
    Unit cur; if (!S.next(0, cur)) return;
    if (wid < 4) {
        const int cw = wid, fr = lane & 15, fq = lane >> 4;
        const int pj = lane >> 3; const unsigned pch = (unsigned)(((lane & 7) ^ pj) * 16);
        unsigned ao[8], an[8];
#pragma unroll
        for (int i = 0; i < 8; ++i) ao[i] = S.arow_off(cur, cw * 64 + 8 * i + pj) + pch;
        const char* const Ab = S.abase();
#define LC_ISSUE_A(stage, OFF, kt) do { const char* g_ = Ab + (size_t)(kt) * 128; _Pragma("unroll") for (int i = 0; i < 8; ++i) \
            __builtin_amdgcn_global_load_lds((const unsigned*)(g_ + OFF[i]), (LC_LAS unsigned*)(lds + A_OFF + (stage) * A_STAGE + (cw * 8 + i) * 1024), 16, 0, 0); } while (0)
        f32x4 acc[4][8];
#pragma unroll
        for (int m = 0; m < 4; ++m)
#pragma unroll
            for (int n = 0; n < 8; ++n) acc[m][n] = (f32x4){0.f, 0.f, 0.f, 0.f};
        const int arow = A_OFF + (cw * 64 + fr) * 128, aoff0 = arow + ((fq ^ (fr & 7)) * 16), aoff1 = arow + (((4 + fq) ^ (fr & 7)) * 16), boff = B_OFF + (fq * 128 + fr) * 16;
        LC_ISSUE_A(0, ao, 0); LC_ISSUE_A(1, ao, 1);
        asm volatile("s_waitcnt vmcnt(8)" ::: "memory"); LC_BAR();
        int gs = 0, bs = 0, ui = 0;
        for (;;) {
            Unit nxt; const bool has_next = S.next(ui + 1, nxt);
#pragma unroll
            for (int i = 0; i < 8; ++i) an[i] = has_next ? S.arow_off(nxt, cw * 64 + 8 * i + pj) + pch : ao[i];
#pragma unroll 1
            for (int t = 0; t < nt; ++t) {
                const int s2 = gs + 2 >= 3 ? gs - 1 : gs + 2;
                const bool own = t + 2 < nt;
                const char* g2 = Ab + (size_t)(own ? t + 2 : t + 2 - nt) * 128;
                const LC_LAS unsigned char* As = lds + gs * A_STAGE; const LC_LAS unsigned char* Bp = lds + bs * B_STAGE + boff;
#pragma unroll
                for (int kk = 0; kk < 2; ++kk) {
                    bf16x8 af[4], bfr[8];
#pragma unroll
                    for (int m = 0; m < 4; ++m) af[m] = *(const LC_LAS bf16x8*)(As + (kk ? aoff1 : aoff0) + m * 2048);
#pragma unroll
                    for (int n = 0; n < 8; ++n) bfr[n] = *(const LC_LAS bf16x8*)(Bp + n * 256 + kk * 8192);
#pragma unroll
                    for (int m = 0; m < 4; ++m) {
                        __builtin_amdgcn_s_setprio(1);
#pragma unroll
                        for (int n = 0; n < 8; ++n) acc[m][n] = __builtin_amdgcn_mfma_f32_16x16x32_bf16(bfr[n], af[m], acc[m][n], 0, 0, 0);
                        __builtin_amdgcn_s_setprio(0);
                        __builtin_amdgcn_global_load_lds((const unsigned*)(g2 + (own ? ao[kk * 4 + m] : an[kk * 4 + m])), (LC_LAS unsigned*)(lds + A_OFF + s2 * A_STAGE + (cw * 8 + kk * 4 + m) * 1024), 16, 0, 0);
                        __builtin_amdgcn_sched_barrier(0);
                    }
                }
                asm volatile("s_waitcnt vmcnt(8) lgkmcnt(0)" ::: "memory"); LC_BAR();
                gs = gs == 2 ? 0 : gs + 1; bs ^= 1;
            }
            E(acc, cur, cw, fr, fq);
            if (!has_next) break;
#pragma unroll
            for (int m = 0; m < 4; ++m)
#pragma unroll
                for (int n = 0; n < 8; ++n) acc[m][n] = (f32x4){0.f, 0.f, 0.f, 0.f};
            cur = nxt; ++ui;
#pragma unroll
            for (int i = 0; i < 8; ++i) ao[i] = an[i];
        }
        asm volatile("s_waitcnt vmcnt(0)" ::: "memory");
#undef LC_ISSUE_A
    } else {
        const int ltid = tid - 256, n4 = ltid & 31, kq = ltid >> 5;
        const int pitch = S.bpitch();
        const int rot = n4 & 3;
        int wo[4];
#pragma unroll
        for (int c = 0; c < 4; ++c) wo[c] = B_OFF + (kq * 128 + 4 * n4 + ((c + rot) & 3)) * 16;
        f32x4 rb[D][8];
        Unit lu = cur; int li = 0, lk = 0; const float* lp = S.bsrc(lu, 4 * n4) + (size_t)(kq * 8) * pitch;
#define LC_LOAD(slot) do { const float* p_ = lp + (size_t)lk * 64 * pitch; _Pragma("unroll") for (int j = 0; j < 8; ++j) rb[slot][j] = *(const f32x4*)(p_ + (size_t)j * pitch); \
            if (++lk == nt) { lk = 0; Unit nu; if (S.next(li + 1, nu)) { lu = nu; ++li; lp = S.bsrc(lu, 4 * n4) + (size_t)(kq * 8) * pitch; } } } while (0)
#define LC_ROT(v) ({ f32x4 a_ = (rot & 1) ? (f32x4){(v)[1], (v)[2], (v)[3], (v)[0]} : (v); (rot & 2) ? (f32x4){a_[2], a_[3], a_[0], a_[1]} : a_; })
#define LC_WRITE(slot, stage) do { f32x4 q_[8]; _Pragma("unroll") for (int j = 0; j < 8; ++j) q_[j] = LC_ROT(rb[slot][j]); \
            _Pragma("unroll") for (int c = 0; c < 4; ++c) { pg8::u32x4 w_; \
            w_.x = pg8::cvt_pk_bf16(q_[0][c], q_[1][c]); w_.y = pg8::cvt_pk_bf16(q_[2][c], q_[3][c]); \
            w_.z = pg8::cvt_pk_bf16(q_[4][c], q_[5][c]); w_.w = pg8::cvt_pk_bf16(q_[6][c], q_[7][c]); \
            *(LC_LAS pg8::u32x4*)(lds + (stage) * B_STAGE + wo[c]) = w_; } } while (0)
        LC_LOAD(0); LC_LOAD(1); LC_LOAD(2); LC_LOAD(3);
        LC_WRITE(0, 0); LC_LOAD(0);
        asm volatile("s_waitcnt lgkmcnt(0)" ::: "memory"); LC_BAR();
        int ui = 0;
        for (;;) {
            Unit nxt; const bool has_next = S.next(ui + 1, nxt);
#pragma unroll 1
            for (int t = 0; t < nt; t += 4) {
                LC_WRITE(1, 1); LC_LOAD(1); asm volatile("s_waitcnt lgkmcnt(0)" ::: "memory"); LC_BAR();
                LC_WRITE(2, 0); LC_LOAD(2); asm volatile("s_waitcnt lgkmcnt(0)" ::: "memory"); LC_BAR();
                LC_WRITE(3, 1); LC_LOAD(3); asm volatile("s_waitcnt lgkmcnt(0)" ::: "memory"); LC_BAR();
                LC_WRITE(0, 0); LC_LOAD(0); asm volatile("s_waitcnt lgkmcnt(0)" ::: "memory"); LC_BAR();
            }
            if (!has_next) break;
            ++ui;
        }
        asm volatile("s_waitcnt vmcnt(0)" ::: "memory");
#undef LC_LOAD
#undef LC_WRITE
#undef LC_ROT
    }
    LC_BAR();
}
}
namespace att {
constexpr int D = 128;
constexpr float SCALE = 0.08838834764831845f;
constexpr float THR = 8.f;
constexpr int NW = 8, QBLK = 32, KVBLK = 64, QB = NW * QBLK;
constexpr int SHM_V = KVBLK * D * 2, SHM_K = KVBLK * D * 2;
constexpr int LDS_WS = 2 * SHM_V + 2 * SHM_K;
constexpr int LDS_BIAS = LDS_WS + NW * 64 * 4;
constexpr int LDS_BYTES = LDS_BIAS + 4096 * 4;
typedef unsigned short bf16;
typedef short bf16x8 __attribute__((ext_vector_type(8)));
typedef short s16x4 __attribute__((ext_vector_type(4)));
typedef float f32x16 __attribute__((ext_vector_type(16)));
typedef float f32x4 __attribute__((ext_vector_type(4)));
typedef unsigned u32x4 __attribute__((ext_vector_type(4)));
#define ATT_LAS __attribute__((address_space(3)))

#define KSWZ(row, colB) ((row) * 256 + ((colB) ^ (((row) & 7) << 4)))
#define SBAR() __builtin_amdgcn_sched_barrier(0)
__device__ __forceinline__ int v_st(int k, int c) { const int kk = (k & ~0xC) | ((k & 4) << 1) | ((k & 8) >> 1); return ((kk >> 3) * 4 + (c >> 5)) * 512 + ((kk & 7) * 32 + (c & 31)) * 2; }
__device__ __forceinline__ int v_rd_base(int lane) { return ((lane & 3) << 3) | (((lane >> 2) & 3) << 6) | (((lane >> 4) & 1) << 5) | (((lane >> 5) & 1) << 8); }
constexpr int v_rd_off(int d0, int ks, int half) { return d0 * 512 + ks * 4096 + half * 2048; }
__device__ __forceinline__ int crow(int r, int hi) { return (r & 3) + 8 * (r >> 2) + 4 * hi; }
__device__ __forceinline__ unsigned cvtpk(float lo, float hi) { unsigned r; asm volatile("v_cvt_pk_bf16_f32 %0, %1, %2" : "=v"(r) : "v"(lo), "v"(hi)); return r; }
__device__ __forceinline__ bf16x8 load8(const bf16* p) { return *reinterpret_cast<const bf16x8*>(p); }

__device__ __forceinline__ void mask_tile(f32x16& p0, f32x16& p1, int dq, unsigned W) {
    const float NEG = -__builtin_inff();
#pragma unroll
    for (int r = 0; r < 16; ++r) {
        const int c = (r & 3) + 8 * (r >> 2);
        if ((unsigned)(dq - c) >= W) p0[r] = NEG;
        if ((unsigned)(dq - c - 32) >= W) p1[r] = NEG;
    }
}
__device__ __forceinline__ void mask_bits(f32x16& p0, f32x16& p1, unsigned long long w, int hi) {
    const float NEG = -__builtin_inff();
    const unsigned lo = (unsigned)w >> (4 * hi), hh = (unsigned)(w >> 32) >> (4 * hi);
#pragma unroll
    for (int r = 0; r < 16; ++r) {
        const int c = (r & 3) + 8 * (r >> 2);
        if (!((lo >> c) & 1u)) p0[r] = NEG;
        if (!((hh >> c) & 1u)) p1[r] = NEG;
    }
}
__device__ __forceinline__ void partialSM(f32x16& p0, f32x16& p1, float& m_reg, float& mn, float& alpha) {
    float pmax = p0[0]; for (int r = 1; r < 16; ++r) pmax = fmaxf(pmax, p0[r]); for (int r = 0; r < 16; ++r) pmax = fmaxf(pmax, p1[r]);
    { auto rr = __builtin_amdgcn_permlane32_swap(__float_as_uint(pmax), __float_as_uint(pmax), false, false);
      pmax = fmaxf(__uint_as_float(rr[0]), __uint_as_float(rr[1])); }
    constexpr float C2 = 1.4426950408889634f * SCALE;
    if (__builtin_expect(__all((pmax - m_reg) * SCALE <= THR), 1)) { mn = m_reg; alpha = 1.f; }
    else { mn = fmaxf(m_reg, pmax); alpha = __builtin_amdgcn_exp2f((m_reg - mn) * C2); m_reg = mn; }
    const float mnL = -mn * C2;
    for (int r = 0; r < 16; ++r) p0[r] = fmaf(p0[r], C2, mnL); for (int r = 0; r < 16; ++r) p1[r] = fmaf(p1[r], C2, mnL);
    for (int r = 0; r < 16; ++r) p0[r] = __builtin_amdgcn_exp2f(p0[r]);
}
__device__ __forceinline__ void finishSM(f32x16& p0, f32x16& p1, float alpha, float& l_reg, bf16x8& pa0, bf16x8& pa1, bf16x8& pa2, bf16x8& pa3) {
    for (int r = 0; r < 16; ++r) p1[r] = __builtin_amdgcn_exp2f(p1[r]);
    float ps = 0; for (int r = 0; r < 16; ++r) ps += p0[r]; for (int r = 0; r < 16; ++r) ps += p1[r];
    { auto rr = __builtin_amdgcn_permlane32_swap(__float_as_uint(ps), __float_as_uint(ps), false, false);
      ps = __uint_as_float(rr[0]) + __uint_as_float(rr[1]); }
    l_reg = l_reg * alpha + ps;
#define PK4(P, B_, OUT) do { unsigned a0 = cvtpk(P[B_+0], P[B_+1]), a1 = cvtpk(P[B_+2], P[B_+3]);                          \
        unsigned b0 = cvtpk(P[B_+4], P[B_+5]), b1 = cvtpk(P[B_+6], P[B_+7]);                                             \
        auto r0 = __builtin_amdgcn_permlane32_swap(a0, b0, false, false); auto r1 = __builtin_amdgcn_permlane32_swap(a1, b1, false, false); \
        u32x4 w = {r0[0], r1[0], r0[1], r1[1]}; OUT = *reinterpret_cast<bf16x8*>(&w); } while (0)
    PK4(p0, 0, pa0); PK4(p0, 8, pa1); PK4(p1, 0, pa2); PK4(p1, 8, pa3);
#undef PK4
}
template <int KB, int MODE>
__device__ __forceinline__ void qkt(f32x16& p0, f32x16& p1, const char* K_lds, int r32, int hi, const bf16x8* qr, const ATT_LAS float* bias_tile) {
    if constexpr (MODE == 1) {
        const ATT_LAS float* bp = bias_tile + 4 * hi;
#pragma unroll
        for (int g = 0; g < 4; ++g) { const f32x4 a = *(const ATT_LAS f32x4*)(bp + 8 * g), b = *(const ATT_LAS f32x4*)(bp + 32 + 8 * g);
            p0[4 * g] = a[0]; p0[4 * g + 1] = a[1]; p0[4 * g + 2] = a[2]; p0[4 * g + 3] = a[3];
            p1[4 * g] = b[0]; p1[4 * g + 1] = b[1]; p1[4 * g + 2] = b[2]; p1[4 * g + 3] = b[3]; }
    } else { p0 = f32x16{}; p1 = f32x16{}; }
    const char* kb[4];
#pragma unroll
    for (int dd = 0; dd < 4; ++dd) kb[dd] = K_lds + KB * SHM_K + KSWZ(r32, (dd * 16 + hi * 8) * 2);
#pragma unroll
    for (int d0 = 0; d0 < 8; ++d0) { const char* a = kb[d0 & 3] + (d0 >> 2) * 128;
        bf16x8 b0 = *reinterpret_cast<const bf16x8*>(a);
        bf16x8 b1 = *reinterpret_cast<const bf16x8*>(a + 32 * 256);
        p0 = __builtin_amdgcn_mfma_f32_32x32x16_bf16(b0, qr[d0], p0, 0, 0, 0);
        p1 = __builtin_amdgcn_mfma_f32_32x32x16_bf16(b1, qr[d0], p1, 0, 0, 0); }
}
template <int VB>
__device__ __forceinline__ void pv_tile(f32x16* o, int vb0, bf16x8 pa0, bf16x8 pa1, bf16x8 pa2, bf16x8 pa3) {
#define TRRD(dst, off) asm volatile("ds_read_b64_tr_b16 %0, %1 offset:%2" : "=&v"(dst) : "v"(vb0), "i"(off) : "memory")
#define PV_D0(d0) do { s16x4 l0, l1, l2, l3, h0, h1, h2, h3; constexpr int b_ = VB * SHM_V + v_rd_off(d0, 0, 0); \
        TRRD(l0, b_); TRRD(h0, b_ + 2048); TRRD(l1, b_ + 4096); TRRD(h1, b_ + 6144); TRRD(l2, b_ + 8192); TRRD(h2, b_ + 10240); TRRD(l3, b_ + 12288); TRRD(h3, b_ + 14336); \
        asm volatile("s_waitcnt lgkmcnt(0)" ::: "memory"); SBAR();   \
        o[d0] = __builtin_amdgcn_mfma_f32_32x32x16_bf16(pa0, (bf16x8){l0[0], l0[1], l0[2], l0[3], h0[0], h0[1], h0[2], h0[3]}, o[d0], 0, 0, 0);   \
        o[d0] = __builtin_amdgcn_mfma_f32_32x32x16_bf16(pa1, (bf16x8){l1[0], l1[1], l1[2], l1[3], h1[0], h1[1], h1[2], h1[3]}, o[d0], 0, 0, 0);   \
        o[d0] = __builtin_amdgcn_mfma_f32_32x32x16_bf16(pa2, (bf16x8){l2[0], l2[1], l2[2], l2[3], h2[0], h2[1], h2[2], h2[3]}, o[d0], 0, 0, 0);   \
        o[d0] = __builtin_amdgcn_mfma_f32_32x32x16_bf16(pa3, (bf16x8){l3[0], l3[1], l3[2], l3[3], h3[0], h3[1], h3[2], h3[3]}, o[d0], 0, 0, 0); } while (0)
    PV_D0(0); PV_D0(1); PV_D0(2); PV_D0(3);
#undef PV_D0
#undef TRRD
}

struct BlockRef { const bf16* Q; const bf16* K; const bf16* V; bf16* O; int P0; const unsigned long long* mrow; };
struct Seam { bf16x8 qr[8]; bf16x8 st_v0, st_v1, st_k0, st_k1; };
__device__ __forceinline__ int swa_jlo(int P0, int W) { const int lowk = P0 - W + 1; return lowk > 0 ? lowk / KVBLK : 0; }
#define ROW(p, k0, rr) ((p) + (size_t)((k0) + (rr)) * D + sc)
#define VMW() asm volatile("s_waitcnt vmcnt(0)" ::: "memory")
#define VMWN(n) asm volatile("s_waitcnt vmcnt(%0)" :: "i"(n) : "memory")
#define SLOAD_H(Kp, Vp, k0) do { S.st_v0 = load8(ROW(Vp, k0, sr)); S.st_v1 = load8(ROW(Vp, k0, 32 + sr));              \
                         S.st_k0 = load8(ROW(Kp, k0, sr)); S.st_k1 = load8(ROW(Kp, k0, 32 + sr)); } while (0)
#define SWRITE_HK(bf) do { *(bf16x8*)(K_lds + (bf) * SHM_K + kws) = S.st_k0; *(bf16x8*)(K_lds + (bf) * SHM_K + kws + 32 * 256) = S.st_k1; } while (0)
#define SWRITE_HV(bf) do { *(bf16x8*)(V_lds + (bf) * SHM_V + vst0) = S.st_v0; *(bf16x8*)(V_lds + (bf) * SHM_V + vst1) = S.st_v1; } while (0)
#define SWRITE_H(bf) do { SWRITE_HV(bf); SWRITE_HK(bf); } while (0)
__device__ __forceinline__ void attn_prime(const BlockRef& cur, int W, char* lds, Seam& S) {
    const int tid = threadIdx.x, wid = __builtin_amdgcn_readfirstlane(tid >> 6), lane = tid & 63, r32 = lane & 31, hi = lane >> 5;
    const int sr = tid >> 4, sc = (tid & 15) * 8, kws = KSWZ(sr, sc * 2); char* K_lds = lds + 2 * SHM_V;
    const int kb0 = swa_jlo(cur.P0, W) * KVBLK;
    for (int d0 = 0; d0 < 8; ++d0) S.qr[d0] = load8(cur.Q + (size_t)(wid * QBLK + r32) * D + d0 * 16 + hi * 8);
    SLOAD_H(cur.K, cur.V, kb0); VMW(); SWRITE_HK(0);
    __syncthreads();
}
template <int MODE>
__device__ __forceinline__ void attn_block(const BlockRef& cur, const BlockRef& nxt, int skv, int W, int ldo, char* lds, Seam& S) {
    const int tid = threadIdx.x, wid = __builtin_amdgcn_readfirstlane(tid >> 6), lane = tid & 63, r32 = lane & 31, hi = lane >> 5;
    const int j_lo = swa_jlo(cur.P0, W);
    int j_hi = (cur.P0 + QB - 1) / KVBLK + 1; if (j_hi > skv / KVBLK) j_hi = skv / KVBLK;
    const int NT = j_hi - j_lo;
    const int kbn = swa_jlo(nxt.P0, W) * KVBLK;
    const int qlo = cur.P0 + wid * QBLK, qm = qlo + r32 - 4 * hi;
    char* V_lds = lds; char* K_lds = lds + 2 * SHM_V;
    float* ws = (float*)(lds + LDS_WS) + wid * 64; float* li_l = ws, * al_l = ws + 32;
    const ATT_LAS float* bias_l = (const ATT_LAS float*)(ATT_LAS char*)(lds + LDS_BIAS);
    float m_reg = -1e30f, l_reg = 0; f32x16 o[4] = {};
    const int sr = tid >> 4, sc = (tid & 15) * 8, vst0 = v_st(sr, sc), vst1 = v_st(32 + sr, sc), kws = KSWZ(sr, sc * 2);
    const int vb0 = (int)(uintptr_t)V_lds + v_rd_base(lane);
    const bf16* Kh = cur.K; const bf16* Vh = cur.V;
    const unsigned long long* mw = (MODE == 2) ? cur.mrow + (size_t)(wid * QBLK + r32) * 64 + j_lo : nullptr;
    unsigned long long mwA = 0, mwB = 0;
#define RESC(a) do { if (__any((a) < 1.f)) { if (hi == 0) al_l[r32] = (a); asm volatile("s_waitcnt lgkmcnt(0)" ::: "memory");              \
                     for (int d_ = 0; d_ < 4; ++d_) for (int r = 0; r < 16; ++r) o[d_][r] *= al_l[crow(r, hi)]; } } while (0)
#define KBASE(t) ((j_lo + (t)) * KVBLK)
#define BIAS_T(t) (bias_l + KBASE(t))
#define MASKT(P0_, P1_, MW_, t) do { if constexpr (MODE == 2) { mask_bits(P0_, P1_, MW_, hi); } else if constexpr (MODE != 3) { const int kb_ = KBASE(t); \
        if (kb_ + KVBLK - 1 > qlo || kb_ <= qlo + QBLK - 1 - W) mask_tile(P0_, P1_, qm - kb_, (unsigned)W); } } while (0)
#define LOADW(MW_, t) do { if constexpr (MODE == 2) { MW_ = mw[(t)]; } } while (0)
    constexpr int NQL = 8;
#define SEAM_K0() do { VMWN(NQL); SWRITE_HK(0); SBAR(); } while (0)
    f32x16 pA0, pA1, pB0, pB1; float mnA, mnB, alA, alB; bf16x8 pa0, pa1, pa2, pa3;
    SWRITE_HV(0); SBAR();
    LOADW(mwA, 0);
    if (NT > 1) { SLOAD_H(Kh, Vh, KBASE(1)); }
    SBAR(); qkt<0, MODE>(pA0, pA1, K_lds, r32, hi, S.qr, BIAS_T(0));
    MASKT(pA0, pA1, mwA, 0); partialSM(pA0, pA1, m_reg, mnA, alA);
    if (NT > 1) { VMW(); SWRITE_H(1); }
    __syncthreads();
#define HALF_STEP(PX0, PX1, mnX, alX, MWX, PY0, PY1, alY, t, KB, VB, SB) do {                                               \
        SBAR(); LOADW(MWX, t); qkt<KB, MODE>(PX0, PX1, K_lds, r32, hi, S.qr, BIAS_T(t));                                      \
        finishSM(PY0, PY1, alY, l_reg, pa0, pa1, pa2, pa3); SBAR();                                                           \
        if ((t) + 1 < NT) { SLOAD_H(Kh, Vh, KBASE((t) + 1)); SBAR(); }                                                        \
        pv_tile<VB>(o, vb0, pa0, pa1, pa2, pa3); MASKT(PX0, PX1, MWX, (t)); partialSM(PX0, PX1, m_reg, mnX, alX);             \
        __syncthreads();                                                                                                      \
        if ((t) + 1 < NT) { VMW(); SWRITE_H(SB); }                                                                            \
        RESC(alX); __syncthreads(); } while (0)
    for (int t = 1; t + 1 < NT; t += 2) {
        HALF_STEP(pB0, pB1, mnB, alB, mwB, pA0, pA1, alA, t, 1, 0, 0);
        HALF_STEP(pA0, pA1, mnA, alA, mwA, pB0, pB1, alB, t + 1, 0, 1, 1);
    }
    const bool even = (NT & 1) == 0;
    if (even) { SBAR(); LOADW(mwB, NT - 1); qkt<1, MODE>(pB0, pB1, K_lds, r32, hi, S.qr, BIAS_T(NT - 1)); SBAR(); }
    SLOAD_H(nxt.K, nxt.V, kbn); SBAR();
#pragma unroll
    for (int d0 = 0; d0 < 8; ++d0) S.qr[d0] = load8(nxt.Q + (size_t)(wid * QBLK + r32) * D + d0 * 16 + hi * 8);
    SBAR();
    finishSM(pA0, pA1, alA, l_reg, pa0, pa1, pa2, pa3); SBAR();
    pv_tile<0>(o, vb0, pa0, pa1, pa2, pa3);
    if (even) { MASKT(pB0, pB1, mwB, NT - 1); partialSM(pB0, pB1, m_reg, mnB, alB); __syncthreads(); RESC(alB);
        finishSM(pB0, pB1, alB, l_reg, pa0, pa1, pa2, pa3); SBAR(); pv_tile<1>(o, vb0, pa0, pa1, pa2, pa3); }
    SBAR(); SEAM_K0();
    if (hi == 0) li_l[r32] = l_reg; asm volatile("s_waitcnt lgkmcnt(0)" ::: "memory");
    float rli[16];
#pragma unroll
    for (int r = 0; r < 16; ++r) rli[r] = __builtin_amdgcn_rcpf(li_l[crow(r, hi)]);
    bf16* Ow = cur.O + (size_t)(wid * QBLK) * ldo;
#pragma unroll
    for (int r = 0; r < 16; ++r) { const int orow = crow(r, hi);
#pragma unroll
        for (int d0 = 0; d0 < 4; ++d0) { const float v = o[d0][r] * rli[r];
            const float vn = __shfl_xor(v, 1);
            if ((r32 & 1) == 0) *(unsigned*)(Ow + (size_t)orow * ldo + d0 * 32 + r32) = cvtpk(v, vn); } }
    __syncthreads();
#undef RESC
#undef KBASE
#undef BIAS_T
#undef MASKT
#undef LOADW
#undef SEAM_K0
#undef HALF_STEP
}
#undef ROW
#undef VMW
#undef VMWN
#undef SLOAD_H
#undef SWRITE_HK
#undef SWRITE_HV
#undef SWRITE_H
}
struct Args {
    const float* x; const float* mem; const int* positions; const float* attn_norm_g; const float* mem_norm_g; const float* w_in; const float* fox_forget_b;
    const float* fox_q_norm_g; const float* fox_k_norm_g; const float* dsa_q_norm_g; const float* dsa_k_norm_g; const float* idx_k_norm_g;
    const float* cross_q_norm_g; const float* cross_k_norm_g; const float* w_mem_kv; const float* w_branch_fox; const float* w_branch_dsa;
    const float* w_branch_cross; const float* w_out; const float* ffn_norm_g; const float* router_group_w; const float* router_group_b;
    const float* router_expert_w; const float* router_expert_b; const float* expert_w_gate; const float* expert_w_up; const float* expert_w_down;
    float* out; unsigned char* ws; int ph_lo, ph_hi, flags, pad;
};
static_assert(sizeof(Args) == 29 * 8 + 16, "Args has no padding");

struct Frame { int tid, lane, wave, G, c, vcu; };

#define XB_TMO      128
#define XB_XCNT(j)  (256  + 64 * (j))
#define XB_XSUB(j)  (1280 + 64 * (j))
#define XB_XGEN(j)  (2304 + 64 * (j))
#define XB_TOP      3328
#define XB_TOPGEN   3392
#define XCD_BAR_WORDS 3456
#define XB_SPIN_CAP (1u << 22)
__device__ __forceinline__ unsigned xb_ld(unsigned* p)              { return __hip_atomic_load(p, __ATOMIC_RELAXED, __HIP_MEMORY_SCOPE_AGENT); }
__device__ __forceinline__ unsigned xb_add(unsigned* p, unsigned v) { return __hip_atomic_fetch_add(p, v, __ATOMIC_RELAXED, __HIP_MEMORY_SCOPE_AGENT); }
__device__ __forceinline__ unsigned xb_xcc_id() { return (unsigned)__builtin_amdgcn_s_getreg((3 << 11) | 20) & 0xFu; }
#define XB_SPIN(cond, bar) do { unsigned _sp = 0; while (cond) { __builtin_amdgcn_s_sleep(1); \
    if ((++_sp & 255u) == 0u) { if (xb_ld(&(bar)[XB_TMO])) break; if (_sp > XB_SPIN_CAP) { atomicAdd(&(bar)[XB_TMO], 1u); break; } } } } while (0)
struct XcdBarrier { unsigned* bar; unsigned x; volatile LAS unsigned* st; };
__device__ __forceinline__ XcdBarrier xcd_barrier_post(unsigned* bar, volatile LAS unsigned* st) {
    XcdBarrier b; b.bar = bar; b.x = xb_xcc_id(); b.st = st;
    if (threadIdx.x == 0) (void)xb_add(&bar[XB_XCNT(b.x)], 1u);
    return b;
}
__device__ __forceinline__ void xcd_barrier_complete(unsigned* bar, unsigned x, unsigned& nloc, unsigned& nx) {
    const unsigned G = gridDim.x * gridDim.y * gridDim.z;
    unsigned sum, cnt, mine, sp = 0u;
    for (;;) {
        sum = 0u; cnt = 0u; mine = 0u;
#pragma unroll
        for (unsigned j = 0; j < 16; ++j) { const unsigned c = xb_ld(&bar[XB_XCNT(j)]); sum += c; cnt += (c > 0u) ? 1u : 0u; mine = (j == x) ? c : mine; }
        if (sum == G) break;
        __builtin_amdgcn_s_sleep(1);
        if ((++sp & 255u) == 0u) { if (xb_ld(&bar[XB_TMO])) break; if (sp > XB_SPIN_CAP) { atomicAdd(&bar[XB_TMO], 1u); break; } }
    }
    nloc = mine > 0u ? mine : 1u; nx = cnt > 0u ? cnt : 1u;
}
__device__ __forceinline__ void xcd_barrier(const XcdBarrier& b) {
    asm volatile("s_waitcnt vmcnt(0)" ::: "memory");
    __syncthreads();
    if (threadIdx.x == 0) {
        unsigned* bar = b.bar;
        __builtin_amdgcn_s_waitcnt(0);
        unsigned nloc = b.st[0], nx = b.st[1];
        if (nloc == 0u) { xcd_barrier_complete(bar, b.x, nloc, nx); b.st[0] = nloc; b.st[1] = nx; }
        const unsigned old = xb_add(&bar[XB_XSUB(b.x)], 1u);
        const unsigned gen = old / nloc;
        if (old + 1u == (gen + 1u) * nloc) {
            __builtin_amdgcn_fence(__ATOMIC_RELEASE, "agent");
            asm volatile("s_waitcnt vmcnt(0)" ::: "memory");
            const unsigned og = xb_add(&bar[XB_TOP], 1u);
            const unsigned tg = og / nx;
            if (og + 1u == (tg + 1u) * nx) xb_add(&bar[XB_TOPGEN], 1u);
            else XB_SPIN(xb_ld(&bar[XB_TOPGEN]) == tg, bar);
            __builtin_amdgcn_fence(__ATOMIC_ACQUIRE, "agent");
            xb_add(&bar[XB_XGEN(b.x)], 1u);
            asm volatile("s_waitcnt vmcnt(0)" ::: "memory");
        } else {
            XB_SPIN(xb_ld(&bar[XB_XGEN(b.x)]) == gen, bar);
            __builtin_amdgcn_fence(__ATOMIC_ACQUIRE, "agent");
            asm volatile("s_waitcnt vmcnt(0)" ::: "memory");
        }
    }
    __syncthreads();
}


struct TItem { const float* colp; bf16* WT; int srcN, k0, drow0, K; };
__device__ __forceinline__ void titem_load(const TItem& t, float (&v)[32], int lane) {
#pragma unroll
    for (int i = 0; i < 32; ++i) { const int kk = 2 * i + (lane >> 5); v[i] = t.colp ? t.colp[(size_t)(t.k0 + kk) * t.srcN] : 0.f; }
}
__device__ __forceinline__ void titem_store(const TItem& t, const float (&v)[32], LAS float* scr, int lane) {
    const int n = lane & 31;
#pragma unroll
    for (int i = 0; i < 32; ++i) { const int kk = 2 * i + (lane >> 5); scr[kk * 33 + n] = v[i]; }
    LDS_WAIT(); asm volatile("" ::: "memory");
    const int c = lane & 7;
#pragma unroll
    for (int j = 0; j < 4; ++j) { const int nn = (lane >> 3) + 8 * j; const LAS float* s = scr + (8 * c) * 33 + nn;
        v4u o; o.x = pk2(s[0 * 33], s[1 * 33]); o.y = pk2(s[2 * 33], s[3 * 33]); o.z = pk2(s[4 * 33], s[5 * 33]); o.w = pk2(s[6 * 33], s[7 * 33]);
        *(GAS v4u*)(t.WT + (size_t)(t.drow0 + nn) * t.K + t.k0 + 8 * c) = o; }
    LDS_WAIT(); asm volatile("" ::: "memory");
}
__device__ __forceinline__ void rms_row_to_bf16(const float* xrow, const float* g, bf16* orow, int lane) {
    const GAS f32x4* xr = (const GAS f32x4*)xrow + lane; const GAS f32x4* gr = (const GAS f32x4*)g + lane;
    f32x4 v[8]; float s = 0.f;
#pragma unroll
    for (int j = 0; j < 8; ++j) { v[j] = xr[64 * j]; s += (v[j].x * v[j].x + v[j].y * v[j].y) + (v[j].z * v[j].z + v[j].w * v[j].w); }
    const float rs = 1.0f / sqrtf(wave_sum(s) * (1.f / DM) + EPS);
    GAS v2u* o8 = (GAS v2u*)orow + lane;
#pragma unroll
    for (int j = 0; j < 8; ++j) { const f32x4 gg = gr[64 * j]; v2u w; w.x = pk2(v[j].x * rs * gg.x, v[j].y * rs * gg.y); w.y = pk2(v[j].z * rs * gg.z, v[j].w * rs * gg.w); o8[64 * j] = w; }
}
__device__ __forceinline__ void p0_prologue(const Args& A, const Frame& F, LAS unsigned char* lds) {
    LAS float* scr = (LAS float*)(lds + F.wave * 16384);
    const int gw = F.vcu * NWAVES + F.wave, NGW = F.G * NWAVES, lane = F.lane, n = lane & 31;
    unsigned char* ws = A.ws;
    constexpr int I_IN = 32 * (N1 / 32), I_MKV = 32 * 32, I_BF = 12 * 64, I_BC = 8 * 64, I_OUT = 32 * 64, I_GU = 32 * 64, I_D = 16 * 64;
    constexpr int T0 = I_IN, T1 = T0 + I_MKV, T2 = T1 + I_BF, T3 = T2 + I_BF, T4 = T3 + I_BC, T5 = T4 + I_OUT, T6 = T5, T7 = T6;
    auto decode = [&](int it) -> TItem { TItem t;
        if (it < T0) { const int nb = it % (N1 / 32), kb = it / (N1 / 32); const int sc = win_src_col(nb * 32 + n);
            t.colp = sc >= 0 ? A.w_in + sc : nullptr; t.srcN = INW; t.k0 = kb * 64; t.WT = (bf16*)(ws + WS_WIN); t.drow0 = nb * 32; t.K = DM; }
        else if (it < T1) { const int r = it - T0, nb = r % 32, kb = r / 32; t.colp = A.w_mem_kv + nb * 32 + n; t.srcN = 1024; t.k0 = kb * 64; t.WT = (bf16*)(ws + WS_WMKV); t.drow0 = nb * 32; t.K = DM; }
        else if (it < T2) { const int r = it - T1, nb = r % 64, kb = r / 64; t.colp = A.w_branch_fox + nb * 32 + n; t.srcN = DM; t.k0 = kb * 64; t.WT = (bf16*)(ws + WS_WBF); t.drow0 = nb * 32; t.K = DM; }
        else if (it < T3) { const int r = it - T2, nb = r % 64, kb = r / 64; t.colp = A.w_branch_dsa + nb * 32 + n - (size_t)FOXW * DM; t.srcN = DM; t.k0 = FOXW + kb * 64; t.WT = (bf16*)(ws + WS_WBF); t.drow0 = nb * 32; t.K = DM; }
        else if (it < T4) { const int r = it - T3, nb = r % 64, kb = r / 64; t.colp = A.w_branch_cross + nb * 32 + n - (size_t)(FOXW + DSAW) * DM; t.srcN = DM; t.k0 = FOXW + DSAW + kb * 64; t.WT = (bf16*)(ws + WS_WBF); t.drow0 = nb * 32; t.K = DM; }
        else if (it < T5) { const int r = it - T4, nb = r % 64, kb = r / 64; t.colp = A.w_out + nb * 32 + n; t.srcN = DM; t.k0 = kb * 64; t.WT = (bf16*)(ws + WS_WOUT); t.drow0 = nb * 32; t.K = DM; }
        else if (it < T6) { const int r = it - T5, e = r / I_GU, q = r % I_GU, nb = q % 64, kb = q / 64;
            t.colp = (n < 16 ? A.expert_w_gate : A.expert_w_up) + (size_t)e * DM * FF + 16 * nb + (n & 15); t.srcN = FF; t.k0 = kb * 64; t.WT = (bf16*)(ws + WS_WGU) + (size_t)e * 2048 * DM; t.drow0 = nb * 32; t.K = DM; }
        else { const int r = it - T6, e = r / I_D, q = r % I_D, nb = q % 64, kb = q / 64;
            t.colp = A.expert_w_down + (size_t)e * FF * DM + nb * 32 + n; t.srcN = DM; t.k0 = kb * 64; t.WT = (bf16*)(ws + WS_WD) + (size_t)e * DM * FF; t.drow0 = nb * 32; t.K = FF; }
        return t; };
    if (gw < T7) {
        float va[32], vb[32]; int it = gw; TItem ta = decode(it), tb; titem_load(ta, va, lane);
        for (;;) {
            int itn = it + NGW; bool hn = itn < T7;
            if (hn) { tb = decode(itn); titem_load(tb, vb, lane); }
            titem_store(ta, va, scr, lane);
            if (!hn) break;
            it = itn; itn = it + NGW; hn = itn < T7;
            if (hn) { ta = decode(itn); titem_load(ta, va, lane); }
            titem_store(tb, vb, scr, lane);
            if (!hn) break;
            it = itn;
        }
    }
    for (int m = gw; m < MTOK + 512; m += NGW) {
        if (m < MTOK) rms_row_to_bf16(A.x + (size_t)m * DM, A.attn_norm_g, (bf16*)(ws + WS_H) + (size_t)m * DM, lane);
        else rms_row_to_bf16(A.mem + (size_t)(m - MTOK) * DM, A.mem_norm_g, (bf16*)(ws + WS_MEMN) + (size_t)(m - MTOK) * DM, lane);
    }
}

struct Sched1 {
    int G, c; const char* H; const char* WIN; const char* WMKV; unsigned memoff;
    static constexpr int NU1 = 32 * 47, NU = NU1 + 8;
    bool tail;
    __device__ __forceinline__ bool next(int i, pg8::Unit& u) const {
        if (tail) { if (i > 0 || c >= 64) return false; u.pm = c & 31; u.pn = 47 + (c >> 5); u.e = 0; u.aux = 0; return true; }
        const int L = i * G + c; if (L >= NU) return false;
        if (L < NU1) { pg8::tile_order(L, 32, 47, u.pm, u.pn); u.e = 0; } else { const int r = L - NU1; u.pm = r >> 2; u.pn = r & 3; u.e = 1; }
        u.aux = 0; return true;
    }
    __device__ __forceinline__ const char* abase() const { return H; }
    __device__ __forceinline__ unsigned arow_off(const pg8::Unit& u, int r) const { return (u.e ? memoff : 0u) + (unsigned)(u.pm * 256 + r) * (unsigned)(DM * 2); }
    __device__ __forceinline__ const char* bbase(const pg8::Unit& u) const { return (u.e ? WMKV : WIN) + (size_t)u.pn * 256 * DM * 2; }
};
struct Epi1 {
    static constexpr bool PERM = true;
    bf16* PROJ; bf16* MKV;
    __device__ __forceinline__ void operator()(const pg8::f32x4 (&acc)[2][2][4][2], const pg8::Unit& u, int wr, int wc, int fr, int fq) const {
        bf16* base = u.e ? MKV : PROJ; const int ldc = u.e ? 1024 : N1;
        const int row0 = u.pm * 256 + wr * 64 + fr, col0 = u.pn * 256 + wc * 32 + 8 * fq;
#pragma unroll
        for (int ai = 0; ai < 2; ++ai)
#pragma unroll
            for (int m = 0; m < 4; ++m) { bf16* rowp = base + (size_t)(row0 + ai * 128 + m * 16) * ldc + col0;
#pragma unroll
                for (int bj = 0; bj < 2; ++bj) { pg8::f32x4 v0 = acc[ai][bj][m][0], v1 = acc[ai][bj][m][1];
                    if (!u.e && (u.pn > 24 || (u.pn == 24 && bj == 1))) {
#pragma unroll
                        for (int j = 0; j < 4; ++j) { v0[j] = 1.0f + __expf(-fminf(fmaxf(v0[j], -30.f), 30.f)); v1[j] = 1.0f + __expf(-fminf(fmaxf(v1[j], -30.f), 30.f)); } }
                    pg8::u32x4 w; w.x = pg8::cvt_pk_bf16(v0[0], v0[1]); w.y = pg8::cvt_pk_bf16(v0[2], v0[3]); w.z = pg8::cvt_pk_bf16(v1[0], v1[1]); w.w = pg8::cvt_pk_bf16(v1[2], v1[3]);
                    *(pg8::u32x4*)(rowp + bj * 128) = w; } }
    }
};

__device__ __forceinline__ float log_sigmoid(float z) { return fminf(z, 0.f) - log1pf(expf(-fabsf(z))); }
__device__ __forceinline__ void head_rms(const bf16* p, const float* g, int lane, float& a, float& b) {
    const unsigned w = *(const unsigned*)(p + 2 * lane); a = bflo(w); b = bfhi(w);
    const float ss = wave_sum(a * a + b * b); const float rs = 1.0f / sqrtf(ss * (1.f / 128.f) + EPS);
    a = a * rs * g[2 * lane]; b = b * rs * g[2 * lane + 1];
}
__device__ __forceinline__ void head_rms_w(unsigned w, const float2 g2, float& a, float& b) {
    a = bflo(w); b = bfhi(w);
    const float ss = wave_sum(a * a + b * b); const float rs = 1.0f / sqrtf(ss * (1.f / 128.f) + EPS);
    a = a * rs * g2.x; b = b * rs * g2.y;
}
struct RopeFreq { float f32a, f32b, f16a, f16b; };
__device__ __forceinline__ RopeFreq rope_freqs(int lane) {
    RopeFreq r; const int i0 = (2 * lane) & 15, i1 = (2 * lane + 1) & 15, l31 = lane & 31, k0 = (2 * l31) & 7, k1 = (2 * l31 + 1) & 7;
    r.f32a = powf(ROPE_THETA, -(float)i0 * 2.0f / 32.0f); r.f32b = powf(ROPE_THETA, -(float)i1 * 2.0f / 32.0f);
    r.f16a = powf(ROPE_THETA, -(float)k0 * 2.0f / 16.0f); r.f16b = powf(ROPE_THETA, -(float)k1 * 2.0f / 16.0f);
    return r;
}
__device__ __forceinline__ void p1b_row(const Args& A, int row, int lane, const RopeFreq& RF) {
    unsigned char* ws = A.ws;
    const bf16* pr = (const bf16*)(ws + WS_PROJ) + (size_t)row * N1;
    const int b = row / SEQ, s = row % SEQ;
    unsigned w[49];
#pragma unroll
    for (int j = 0; j < 49; ++j) w[j] = *(const unsigned*)(pr + 128 * j + 2 * lane);
    const float pos = (float)A.positions[row];
    const float2 gfq = *(const float2*)(A.fox_q_norm_g + 2 * lane), gfk = *(const float2*)(A.fox_k_norm_g + 2 * lane), gdq = *(const float2*)(A.dsa_q_norm_g + 2 * lane),
                 gdk = *(const float2*)(A.dsa_k_norm_g + 2 * lane), gcq = *(const float2*)(A.cross_q_norm_g + 2 * lane);
    float c32a = 1.f, s32a = 0.f, c32b = 1.f, s32b = 0.f;
    if (lane < 16) { sincosf(pos * RF.f32a, &s32a, &c32a); sincosf(pos * RF.f32b, &s32b, &c32b); }
    float c16a = 1.f, s16a = 0.f, c16b = 1.f, s16b = 0.f;
    if ((lane & 31) < 8) { sincosf(pos * RF.f16a, &s16a, &c16a); sincosf(pos * RF.f16b, &s16b, &c16b); }
#pragma unroll
    for (int h = 0; h < 6; ++h) {
        const size_t ho = ((size_t)(b * 6 + h) * SEQ + s) * HD + 2 * lane;
        float a, c;
        head_rms_w(w[h], gfq, a, c); *(unsigned*)((bf16*)(ws + WS_QF) + ho) = pk2(a, c);
        head_rms_w(w[6 + h], gfk, a, c); *(unsigned*)((bf16*)(ws + WS_KF) + ho) = pk2(a, c);
        *(unsigned*)((bf16*)(ws + WS_VF) + ho) = w[12 + h];
        *(unsigned*)((bf16*)(ws + WS_VD) + ho) = w[30 + h];
#pragma unroll
        for (int qk = 0; qk < 2; ++qk) {
            head_rms_w(w[(qk ? 24 : 18) + h], qk ? gdk : gdq, a, c);
            const float pa = __shfl_xor(a, 8), pc = __shfl_xor(c, 8);
            if (lane < 8) { a = a * c32a - pa * s32a; c = c * c32b - pc * s32b; }
            else if (lane < 16) { a = a * c32a + pa * s32a; c = c * c32b + pc * s32b; }
            *(unsigned*)((bf16*)(ws + (qk ? WS_KD : WS_QD)) + ho) = pk2(a, c);
        }
    }
#pragma unroll
    for (int h = 0; h < 4; ++h) { float a, c; head_rms_w(w[36 + h], gcq, a, c);
        *(unsigned*)((bf16*)(ws + WS_QC) + ((size_t)(b * 4 + h) * SEQ + s) * HD + 2 * lane) = pk2(a, c); }
    const int l31 = lane & 31;
#pragma unroll
    for (int hp = 0; hp < 8; ++hp) {
        float a = bflo(w[40 + hp]), c = bfhi(w[40 + hp]);
        const float pa = __shfl_xor(a, 4), pc = __shfl_xor(c, 4);
        if (l31 < 4) { a = a * c16a - pa * s16a; c = c * c16b - pc * s16b; }
        else if (l31 < 8) { a = a * c16a + pa * s16a; c = c * c16b + pc * s16b; }
        *(unsigned*)((bf16*)(ws + WS_QI) + (size_t)row * (IDXH * IDXD) + hp * 128 + 2 * lane) = pk2(a, c);
    }
    { float a = 0.f, c = 0.f; if (lane < 32) { a = bflo(w[48]); c = bfhi(w[48]); }
      const float ss = wave_sum(a * a + c * c); const float rs = 1.0f / sqrtf(ss * (1.f / 64.f) + EPS);
      if (lane < 32) { const float2 gk = *(const float2*)(A.idx_k_norm_g + 2 * lane); a = a * rs * gk.x; c = c * rs * gk.y; }
      const float pa = __shfl_xor(a, 4), pc = __shfl_xor(c, 4);
      if (lane < 4) { a = a * c16a - pa * s16a; c = c * c16b - pc * s16b; }
      else if (lane < 8) { a = a * c16a + pa * s16a; c = c * c16b + pc * s16b; }
      if (lane < 32) { const int d = 2 * lane; *(unsigned*)((bf16*)(ws + WS_KI) + ((size_t)(row >> 5) * 8 + (d >> 3)) * 256 + (row & 31) * 8 + (d & 7)) = pk2(a, c); } }
    if (lane < 16) ((float*)(ws + WS_WI))[(size_t)row * IDXH + lane] = bf2f(pr[C_IW + lane]) * 0.25f;
    if (lane < 6) ((float*)(ws + WS_LOGF))[(size_t)(b * 6 + lane) * SEQ + s] = log_sigmoid(bf2f(pr[C_FL + lane]) + A.fox_forget_b[lane]);
}
__device__ __forceinline__ void p1b_memrow(const Args& A, int mrow, int lane) {
    unsigned char* ws = A.ws; const bf16* pr = (const bf16*)(ws + WS_MKV) + (size_t)mrow * 1024; const int b = mrow / NMEM, m = mrow % NMEM;
#pragma unroll 1
    for (int h = 0; h < 4; ++h) { float a, c; head_rms(pr + h * HD, A.cross_k_norm_g, lane, a, c);
        const size_t ho = ((size_t)(b * 4 + h) * NMEM + m) * HD + 2 * lane;
        *(unsigned*)((bf16*)(ws + WS_KC) + ho) = pk2(a, c);
        *(unsigned*)((bf16*)(ws + WS_VC) + ho) = *(const unsigned*)(pr + 512 + h * HD + 2 * lane); }
}

__device__ __forceinline__ unsigned fkey(float f) { const unsigned u = __builtin_bit_cast(unsigned, f); return (u & 0x80000000u) ? ~u : (u | 0x80000000u); }
__device__ __forceinline__ void indexer_block(const Args& A, const Frame& F, LAS unsigned char* lds, int b, int rb) {
    unsigned char* ws = A.ws; const int lane = F.lane, w = F.wave, r = lane & 31, h = lane >> 5;
    const int t0 = rb * 16, ta = t0 + 2 * w;
    const bf16* QI = (const bf16*)(ws + WS_QI) + (size_t)(b * SEQ) * (IDXH * IDXD);
    const bf16* KI = (const bf16*)(ws + WS_KI) + (size_t)(b * SEQ) * IDXD;
    const float* WI = (const float*)(ws + WS_WI) + (size_t)(b * SEQ) * IDXH;
    float* SC = (float*)(ws + WS_SCORES) + (size_t)(b * SEQ) * SEQ;
    bf16x8 qa[4];
#pragma unroll
    for (int ks = 0; ks < 4; ++ks) qa[ks] = *(const bf16x8*)(QI + (size_t)(ta + (r >> 4)) * (IDXH * IDXD) + (r & 15) * IDXD + ks * 16 + 8 * h);
    float wA[8], wB[8];
#pragma unroll
    for (int q = 0; q < 8; ++q) { const int j = (q & 3) + 8 * (q >> 2) + 4 * h; wA[q] = WI[(size_t)ta * IDXH + j]; wB[q] = WI[(size_t)(ta + 1) * IDXH + j]; }
    const int NT = (A.flags & 2) ? 0 : ((t0 + 16 + 63) >> 6);
    LAS unsigned char* kring = lds + LDSCTL_OFF + 4096;
    const int tid = F.tid;
#define IDX_STAGE(tile_, buf_) __builtin_amdgcn_global_load_lds((const unsigned*)((const char*)KI + (size_t)(tile_) * 8192 + tid * 16), (LAS unsigned*)(kring + (buf_) * 8192 + w * 1024), 16, 0, 0)
    LAS unsigned* rowA = (LAS unsigned*)(lds + w * 16384);
    for (int j = NT >> 2; j < 16; ++j) *(LAS v4u*)(rowA + (j * 64 + lane) * 4) = (v4u){0u, 0u, 0u, 0u};
    __builtin_amdgcn_s_barrier();
    if (NT > 0) IDX_STAGE(0, 0);
#pragma unroll 1
    for (int tile = 0; tile < NT; ++tile) {
        const int kb = tile * 64;
        asm volatile("s_waitcnt vmcnt(0)" ::: "memory"); __builtin_amdgcn_s_barrier();
        if (tile + 1 < NT) IDX_STAGE(tile + 1, (tile + 1) & 1);
        const LAS unsigned char* kt = kring + (tile & 1) * 8192 + (h * 32 + r) * 16;
        bf16x8 k0[4], k1[4];
#pragma unroll
        for (int ks = 0; ks < 4; ++ks) { k0[ks] = *(const LAS bf16x8*)(kt + ks * 1024); k1[ks] = *(const LAS bf16x8*)(kt + 4096 + ks * 1024); }
        f32x16 p0 = {}, p1 = {};
#pragma unroll
        for (int ks = 0; ks < 4; ++ks) { p0 = __builtin_amdgcn_mfma_f32_32x32x16_bf16(qa[ks], k0[ks], p0, 0, 0, 0); p1 = __builtin_amdgcn_mfma_f32_32x32x16_bf16(qa[ks], k1[ks], p1, 0, 0, 0); }
        float sA0 = 0.f, sB0 = 0.f, sA1 = 0.f, sB1 = 0.f;
#pragma unroll
        for (int q = 0; q < 8; ++q) { sA0 += wA[q] * fmaxf(p0[q], 0.f); sB0 += wB[q] * fmaxf(p0[8 + q], 0.f); sA1 += wA[q] * fmaxf(p1[q], 0.f); sB1 += wB[q] * fmaxf(p1[8 + q], 0.f); }
        sA0 += __shfl_xor(sA0, 32); sB0 += __shfl_xor(sB0, 32); sA1 += __shfl_xor(sA1, 32); sB1 += __shfl_xor(sB1, 32);
        if (h) { float* dst = SC + (size_t)(ta + 1) * SEQ + kb + r; dst[0] = sB0; dst[32] = sB1; }
        else { LAS unsigned* d = rowA + ((tile >> 2) * 64 + r) * 4 + (tile & 3);
            d[0] = kb + r <= ta ? fkey(sA0) : 0u; d[128] = kb + 32 + r <= ta ? fkey(sA1) : 0u; }
    }
#undef IDX_STAGE
    VM_WAIT();
#define WAVE_COUNT(c_) ({ int tot_ = 0; _Pragma("unroll") for (int bb = 0; bb < 7; ++bb) tot_ += __popcll(__ballot(((c_) >> bb) & 1)) << bb; tot_; })
#define CNT_GE(c_, k_, s_) asm("v_cmp_le_u32_e32 vcc, %2, %1\n\tv_addc_co_u32_e32 %0, vcc, 0, %0, vcc" : "+v"(c_) : "v"(k_), "s"(s_) : "vcc")
#define CNT_GT(c_, k_, s_) asm("v_cmp_lt_u32_e32 vcc, %2, %1\n\tv_addc_co_u32_e32 %0, vcc, 0, %0, vcc" : "+v"(c_) : "v"(k_), "s"(s_) : "vcc")
#define WAVE_COUNT3(c_) ({ int tot_ = 0; _Pragma("unroll") for (int bb = 0; bb < 3; ++bb) tot_ += __popcll(__ballot(((c_) >> bb) & 1)) << bb; tot_; })
    LAS unsigned* rowl = (LAS unsigned*)(lds + w * 16384);
    LAS unsigned* lst = (LAS unsigned*)(lds + LDSCTL_OFF + 20480 + w * 1536);
    float fb[64];
    { const float* srowB = SC + (size_t)(ta + 1) * SEQ + lane;
#pragma unroll
      for (int i = 0; i < 64; ++i) fb[i] = srowB[i * 64]; }
#pragma unroll 1
    for (int tl = (A.flags & 1) ? 2 : 0; tl < 2; ++tl) {
        const int t = ta + tl;
        unsigned long long myword = 0ull;
        if (t + 1 <= TOPK) {
            const int nb = t + 1 - lane * 64; myword = nb <= 0 ? 0ull : (nb >= 64 ? ~0ull : ((1ull << nb) - 1ull));
        } else {
            if (tl) {
#pragma unroll
                for (int j = 0; j < 16; ++j) { v4u q;
#pragma unroll
                    for (int e = 0; e < 4; ++e) { const int key = 64 * (4 * j + e) + lane; const unsigned k = fkey(fb[4 * j + e]); q[e] = key <= t ? k : 0u; }
                    *(LAS v4u*)(rowl + (j * 64 + lane) * 4) = q; }
            }
            LDS_WAIT();
            unsigned T = 0u; bool exact = false;
            int mx = -1, G = 0;
#pragma unroll 1
            for (int bit = 31; bit >= 0; --bit) {
                if (bit == 17) {
                    const unsigned Thi = T + (1u << 18);
#pragma unroll
                    for (int i = 0; i < 6; ++i) lst[i * 64 + lane] = 0u;
                    int g = 0, nc = 0;
#pragma unroll 4
                    for (int j = 0; j < 16; ++j) { const v4u q = *(const LAS v4u*)(rowl + (j * 64 + lane) * 4);
#pragma unroll
                        for (int e = 0; e < 4; ++e) { const unsigned k = q[e]; CNT_GE(g, k, Thi); const bool cnd = k >= T && k < Thi;
                            if (cnd && nc < 6) lst[nc * 64 + lane] = k;
                            nc += cnd ? 1 : 0; } }
                    LDS_WAIT();
                    if (__ballot(nc > 6) == 0ull) { G = WAVE_COUNT(g); mx = 0; }
                }
                const unsigned cand = T | (1u << bit); int cnt;
                if (mx >= 0) { int c = 0;
#pragma unroll
                    for (int i = 0; i < 6; ++i) c += (lst[i * 64 + lane] >= cand) ? 1 : 0;
                    cnt = G + WAVE_COUNT3(c);
                } else { int c = 0;
#pragma unroll 8
                    for (int j = 0; j < 16; ++j) { const v4u q = *(const LAS v4u*)(rowl + (j * 64 + lane) * 4);
                        CNT_GE(c, q.x, cand); CNT_GE(c, q.y, cand); CNT_GE(c, q.z, cand); CNT_GE(c, q.w, cand); }
                    cnt = WAVE_COUNT(c); }
                if (cnt >= TOPK) { T = cand; if (cnt == TOPK) { exact = true; break; } }
            }
            if (exact) {
                unsigned mlo = 0u, mhi = 0u;
#pragma unroll
                for (int j = 0; j < 16; ++j) { const v4u q = *(const LAS v4u*)(rowl + (j * 64 + lane) * 4);
#pragma unroll
                    for (int e = 0; e < 4; ++e) { const unsigned long long bal = __ballot(q[e] >= T);
                        asm("s_nop 1\n\tv_writelane_b32 %0, %2, %4\n\tv_writelane_b32 %1, %3, %4" : "+v"(mlo), "+v"(mhi) : "s"((unsigned)bal), "s"((unsigned)(bal >> 32)), "n"(4 * j + e)); } }
                myword = ((unsigned long long)mhi << 32) | mlo;
            } else {
            const unsigned thr = T;
            int g0 = 0;
#pragma unroll 4
            for (int j = 0; j < 16; ++j) { const v4u q = *(const LAS v4u*)(rowl + (j * 64 + lane) * 4);
                CNT_GT(g0, q.x, thr); CNT_GT(g0, q.y, thr); CNT_GT(g0, q.z, thr); CNT_GT(g0, q.w, thr); }
            int need = TOPK - WAVE_COUNT(g0);
#pragma unroll 1
            for (int j = 0; j < 16; ++j) { const v4u q = *(const LAS v4u*)(rowl + (j * 64 + lane) * 4);
#pragma unroll
                for (int e = 0; e < 4; ++e) {
                    const unsigned long long eq = __ballot(q[e] == thr); unsigned long long bal = __ballot(q[e] > thr);
                    if (eq != 0ull && need > 0) { const int pc = __popcll(eq);
                        if (pc <= need) { bal |= eq; need -= pc; }
                        else { const int rank = __popcll(eq & ((1ull << lane) - 1ull)); bal |= __ballot(((eq >> lane) & 1ull) && rank < need); need = 0; } }
                    if (lane == 4 * j + e) myword = bal; } }
            }
        }
        ((unsigned long long*)(ws + WS_MASK))[(size_t)(b * SEQ + t) * 64 + lane] = myword;
    }
#undef WAVE_COUNT
#undef WAVE_COUNT3
#undef CNT_GE
#undef CNT_GT
}

__device__ __forceinline__ void fox_bias_scan(const float* logf_bh, char* lds, const Frame& F) {
    const int tid = F.tid, lane = F.lane, w = F.wave;
    float* wsum = (float*)(lds + att::LDS_WS);
    float v[8];
    { const f32x4 a = *(const f32x4*)(logf_bh + 8 * tid), c = *(const f32x4*)(logf_bh + 8 * tid + 4); v[0] = a.x; v[1] = a.y; v[2] = a.z; v[3] = a.w; v[4] = c.x; v[5] = c.y; v[6] = c.z; v[7] = c.w; }
#pragma unroll
    for (int j = 1; j < 8; ++j) v[j] += v[j - 1];
    float inc = v[7];
#pragma unroll
    for (int o = 1; o < 64; o <<= 1) { const float t = __shfl_up(inc, o); if (lane >= o) inc += t; }
    if (lane == 63) wsum[w] = inc;
    __syncthreads();
    float off = inc - v[7];
    for (int k = 0; k < w; ++k) off += wsum[k];
    float* bias = (float*)(lds + att::LDS_BIAS);
    constexpr float NIS = -1.0f / att::SCALE;
    f32x4 o0, o1; o0.x = (off + v[0]) * NIS; o0.y = (off + v[1]) * NIS; o0.z = (off + v[2]) * NIS; o0.w = (off + v[3]) * NIS;
    o1.x = (off + v[4]) * NIS; o1.y = (off + v[5]) * NIS; o1.z = (off + v[6]) * NIS; o1.w = (off + v[7]) * NIS;
    *(f32x4*)(bias + 8 * tid) = o0; *(f32x4*)(bias + 8 * tid + 4) = o1;
    __syncthreads();
}
__device__ __forceinline__ att::BlockRef make_ref(const Args& A, int kind, int item, int pass) {
    unsigned char* ws = A.ws; att::BlockRef r;
    if (kind < 2) { const int bh = item >> 3, x = item & 7, qb = pass ? 15 - x : x, b = bh / 6, h = bh % 6;
        const size_t ho = ((size_t)bh * SEQ) * HD;
        r.Q = (const bf16*)(ws + (kind ? WS_QD : WS_QF)) + ho + (size_t)qb * 256 * HD; r.K = (const bf16*)(ws + (kind ? WS_KD : WS_KF)) + ho; r.V = (const bf16*)(ws + (kind ? WS_VD : WS_VF)) + ho;
        r.O = (bf16*)(ws + WS_OF) + ((size_t)(b * SEQ + qb * 256)) * DM + (kind ? FOXW : 0) + h * HD; r.P0 = qb * 256;
        r.mrow = (const unsigned long long*)(ws + WS_MASK) + (size_t)(b * SEQ + qb * 256) * 64; }
    else { const int bh = item >> 3, x = item & 7, qb = 2 * x + pass, b = bh / 4, h = bh % 4;
        r.Q = (const bf16*)(ws + WS_QC) + ((size_t)bh * SEQ + (size_t)qb * 256) * HD; r.K = (const bf16*)(ws + WS_KC) + (size_t)bh * NMEM * HD; r.V = (const bf16*)(ws + WS_VC) + (size_t)bh * NMEM * HD;
        r.O = (bf16*)(ws + WS_OF) + ((size_t)(b * SEQ + qb * 256)) * DM + FOXW + DSAW + h * HD; r.P0 = 1 << 20; r.mrow = nullptr; }
    return r;
}
template <int MODE, int KIND>
__device__ __forceinline__ void attn_stream(const Args& A, const Frame& F, char* lds, int first, int nitems) {
    constexpr int W = 1 << 30; constexpr int SKV = KIND == 2 ? NMEM : SEQ; constexpr int LDO = DM;
    int L = first; if (L >= nitems) return;
    int pass = 0, cur_bh = -1;
    att::BlockRef cur = make_ref(A, KIND, L, 0);
    att::Seam S;
    att::attn_prime(cur, W, lds, S);
    for (;;) {
        const bool more_pass = pass == 0, more_item = L + F.G < nitems, last = !more_pass && !more_item;
        int passn = pass + 1, Ln = L;
        if (!more_pass) { passn = 0; Ln = more_item ? L + F.G : L; }
        const att::BlockRef nxt = last ? cur : make_ref(A, KIND, Ln, passn);
        if constexpr (MODE == 1) { const int bh = L >> 3; if (bh != cur_bh) { fox_bias_scan((const float*)(A.ws + WS_LOGF) + (size_t)bh * SEQ, lds, F); cur_bh = bh; } }
        att::attn_block<MODE>(cur, nxt, SKV, W, LDO, lds, S);
        if (last) break;
        cur = nxt; pass = passn; L = Ln;
    }
}

struct SchedRows {
    int G, c, nN, K; const char* Ap; const char* Bp;
    __device__ __forceinline__ bool next(int i, pg8::Unit& u) const { const int L = i * G + c; if (L >= 32 * nN) return false; pg8::tile_order(L, 32, nN, u.pm, u.pn); u.e = 0; u.aux = 0; return true; }
    __device__ __forceinline__ const char* abase() const { return Ap; }
    __device__ __forceinline__ unsigned arow_off(const pg8::Unit& u, int r) const { return (unsigned)(u.pm * 256 + r) * (unsigned)(K * 2); }
    __device__ __forceinline__ const char* bbase(const pg8::Unit& u) const { return Bp + (size_t)u.pn * 256 * K * 2; }
};
__device__ __forceinline__ pg8::f32x4 gate4(const bf16* p) { const v2u gw = *(const v2u*)p; pg8::f32x4 g; g[0] = bflo(gw.x); g[1] = bfhi(gw.x); g[2] = bflo(gw.y); g[3] = bfhi(gw.y); return g; }
struct HookMerge {
    static constexpr bool ENABLED = true; const bf16* PROJ;
    __device__ __forceinline__ bool at(int t) const { return t == 12 || t == 24; }
    __device__ __forceinline__ void operator()(pg8::f32x4 (&acc)[2][2][4][2], const pg8::Unit& u, int wr, int wc, int fr, int fq, int t) const {
        asm volatile("" : "+v"(fr), "+v"(fq));
        const int row0 = u.pm * 256 + wr * 64 + fr, col0 = u.pn * 256 + wc * 32 + 4 * fq, ga = (t == 12) ? 0 : 1;
#pragma unroll
        for (int ai = 0; ai < 2; ++ai)
#pragma unroll
            for (int m = 0; m < 4; ++m) { const bf16* gp = PROJ + (size_t)(row0 + ai * 128 + m * 16) * N1 + C_G + ga * DM + col0;
#pragma unroll
                for (int bj = 0; bj < 2; ++bj)
#pragma unroll
                    for (int n = 0; n < 2; ++n) { const pg8::f32x4 ea = gate4(gp + bj * 128 + n * 16), eb = gate4(gp + DM + bj * 128 + n * 16);
#pragma unroll
                        for (int j = 0; j < 4; ++j) acc[ai][bj][m][n][j] *= eb[j] * __builtin_amdgcn_rcpf(ea[j]); }
                if (m == 3) asm volatile("" ::: "memory"); }
    }
};
struct Epi3 {
    static constexpr bool PERM = false;
    const bf16* PROJ; bf16* MERGED;
    __device__ __forceinline__ void operator()(const pg8::f32x4 (&acc)[2][2][4][2], const pg8::Unit& u, int wr, int wc, int fr, int fq) const {
        asm volatile("" : "+v"(fr), "+v"(fq));
        const int row0 = u.pm * 256 + wr * 64 + fr, col0 = u.pn * 256 + wc * 32 + 4 * fq;
#pragma unroll
        for (int ai = 0; ai < 2; ++ai)
#pragma unroll
            for (int m = 0; m < 4; ++m) { const size_t row = (size_t)(row0 + ai * 128 + m * 16);
#pragma unroll
                for (int bj = 0; bj < 2; ++bj)
#pragma unroll
                    for (int n = 0; n < 2; ++n) { const int col = col0 + bj * 128 + n * 16; const pg8::f32x4 e = gate4(PROJ + row * N1 + C_G + 2 * DM + col); pg8::f32x4 v;
#pragma unroll
                        for (int j = 0; j < 4; ++j) v[j] = acc[ai][bj][m][n][j] * __builtin_amdgcn_rcpf(e[j]);
                        v2u w; w.x = pg8::cvt_pk_bf16(v[0], v[1]); w.y = pg8::cvt_pk_bf16(v[2], v[3]); *(v2u*)(MERGED + row * DM + col) = w; } }
    }
};
struct Epi4 {
    static constexpr bool PERM = false;
    const float* X; float* OUT; bf16* X1G; const float* gffn; float* rowss;
    __device__ __forceinline__ void operator()(const pg8::f32x4 (&acc)[2][2][4][2], const pg8::Unit& u, int wr, int wc, int fr, int fq) const {
        const int row0 = u.pm * 256 + wr * 64 + fr, col0 = u.pn * 256 + wc * 32 + 4 * fq;
#pragma unroll
        for (int ai = 0; ai < 2; ++ai)
#pragma unroll
            for (int m = 0; m < 4; ++m) { const size_t row = (size_t)(row0 + ai * 128 + m * 16); float ss = 0.f;
#pragma unroll
                for (int bj = 0; bj < 2; ++bj)
#pragma unroll
                    for (int n = 0; n < 2; ++n) { const int col = col0 + bj * 128 + n * 16;
                        const pg8::f32x4 x1 = *(const pg8::f32x4*)(X + row * DM + col) + acc[ai][bj][m][n];
                        *(pg8::f32x4*)(OUT + row * DM + col) = x1;
                        ss += (x1[0] * x1[0] + x1[1] * x1[1]) + (x1[2] * x1[2] + x1[3] * x1[3]);
                        const pg8::f32x4 gg = *(const pg8::f32x4*)(gffn + col);
                        v2u w; w.x = pg8::cvt_pk_bf16(x1[0] * gg[0], x1[1] * gg[1]); w.y = pg8::cvt_pk_bf16(x1[2] * gg[2], x1[3] * gg[3]); *(v2u*)(X1G + row * DM + col) = w; }
                ss += __shfl_xor(ss, 16); ss += __shfl_xor(ss, 32);
                if (fq == 0) atomicAdd(rowss + row, ss); }
    }
};
typedef float f32x16r __attribute__((ext_vector_type(16)));
__device__ __forceinline__ void router_block(const Args& A, const Frame& F, LAS unsigned char* lds, int tok0) {
    unsigned char* ws = A.ws; const float* X1 = A.out; const float* rowss = (const float*)(ws + WS_CTL) + CW_ROWSS;
    const int lane = F.lane, w = F.wave, i = lane & 31, kk = lane >> 5;
    f32x16r acc0 = {}, acc1 = {};
    const float* xrow = X1 + (size_t)(tok0 + i) * DM + 256 * w;
    const float* gp = A.ffn_norm_g + 256 * w;
    const float* We = A.router_expert_w + (size_t)(256 * w) * NEXP + i;
    const float* Wg = A.router_group_w + (size_t)(256 * w) * NGRP + (i & 3);
#pragma unroll 4
    for (int kq = 0; kq < 64; ++kq) {
        const f32x4 xa = *(const f32x4*)(xrow + 4 * kq) * *(const f32x4*)(gp + 4 * kq);
        const int k0 = 4 * kq + kk;
        const float a0 = kk ? xa[1] : xa[0], a1 = kk ? xa[3] : xa[2];
        const float b00 = We[(size_t)k0 * NEXP], b01 = We[(size_t)(k0 + 2) * NEXP];
        float b10 = Wg[(size_t)k0 * NGRP], b11 = Wg[(size_t)(k0 + 2) * NGRP];
        if (i >= 4) { b10 = 0.f; b11 = 0.f; }
        acc0 = __builtin_amdgcn_mfma_f32_32x32x2f32(a0, b00, acc0, 0, 0, 0);
        acc1 = __builtin_amdgcn_mfma_f32_32x32x2f32(a0, b10, acc1, 0, 0, 0);
        acc0 = __builtin_amdgcn_mfma_f32_32x32x2f32(a1, b01, acc0, 0, 0, 0);
        acc1 = __builtin_amdgcn_mfma_f32_32x32x2f32(a1, b11, acc1, 0, 0, 0);
    }
    LAS float* P = (LAS float*)lds;
    LAS float* R = (LAS float*)(lds + 65536);
#pragma unroll
    for (int r = 0; r < 16; ++r) { const int trow = (r & 3) + 8 * (r >> 2) + 4 * kk;
        P[(w * 32 + trow) * 64 + i] = acc0[r]; P[(w * 32 + trow) * 64 + 32 + i] = acc1[r]; }
    __syncthreads();
    for (int idx = F.tid; idx < 2048; idx += NTHREADS) { float s = 0.f;
#pragma unroll
        for (int q = 0; q < 8; ++q) s += P[q * 2048 + idx];
        R[idx] = s; }
    __syncthreads();
    if (F.tid < 32) {
        const int tok = tok0 + F.tid; const LAS float* lr = R + F.tid * 64;
        const float rs = 1.0f / sqrtf(rowss[tok] * (1.f / DM) + EPS);
        float gl[4];
#pragma unroll
        for (int o = 0; o < 4; ++o) gl[o] = lr[32 + o] * rs + A.router_group_b[o];
        int grp = 0; float gmax = gl[0];
#pragma unroll
        for (int o = 1; o < 4; ++o) if (gl[o] > gmax) { gmax = gl[o]; grp = o; }
        float den = 0.f;
#pragma unroll
        for (int o = 0; o < 4; ++o) den += expf(gl[o] - gmax);
        const float psel = 1.0f / den;
        float el[8];
#pragma unroll
        for (int j = 0; j < 8; ++j) el[j] = lr[grp * 8 + j] * rs + A.router_expert_b[grp * 8 + j];
        int j1 = 0; float l1 = el[0];
#pragma unroll
        for (int j = 1; j < 8; ++j) if (el[j] > l1) { l1 = el[j]; j1 = j; }
        int j2 = -1; float l2 = -__builtin_inff();
#pragma unroll
        for (int j = 0; j < 8; ++j) if (j != j1 && el[j] > l2) { l2 = el[j]; j2 = j; }
        const float e2 = expf(l2 - l1); const float g1 = psel / (1.0f + e2), g2 = psel * e2 / (1.0f + e2);
        unsigned* cnt = (unsigned*)(ws + WS_CTL) + CW_CNT; int* LTOK = (int*)(ws + WS_LTOK); float* LGATE = (float*)(ws + WS_LGATE);
        const int e1i = grp * 8 + j1, e2i = grp * 8 + j2;
        const unsigned p1 = atomicAdd(cnt + e1i, 1u); LTOK[(size_t)e1i * MTOK + p1] = tok * 2; LGATE[(size_t)e1i * MTOK + p1] = g1;
        const unsigned p2 = atomicAdd(cnt + e2i, 1u); LTOK[(size_t)e2i * MTOK + p2] = tok * 2 + 1; LGATE[(size_t)e2i * MTOK + p2] = g2;
    }
    __syncthreads();
}
__device__ __forceinline__ void moe_tables(const Args& A, LAS unsigned char* lds, const Frame& F) {
    LAS int* T = (LAS int*)(lds + LDSCTL_OFF);
    if (F.tid < 64) {
        const unsigned* cnt = (const unsigned*)(A.ws + WS_CTL) + CW_CNT; const int e = F.tid;
        const int c = e < NEXP ? (int)__hip_atomic_load(cnt + e, __ATOMIC_RELAXED, __HIP_MEMORY_SCOPE_AGENT) : 0; const int mt = (c + 255) >> 8;
        int inc = mt;
#pragma unroll
        for (int o = 1; o < 32; o <<= 1) { const int v = __shfl_up(inc, o); if ((e & 31) >= o) inc += v; }
        const int excl = inc - mt;
        if (e < NEXP) { T[e] = excl * 16; T[40 + e] = excl * 256; T[80 + e] = c; }
        if (e == NEXP - 1) { T[32] = inc * 16; T[72] = inc * 256; }
    }
    __syncthreads();
}
struct SchedMoeLC {
    int G, c, K; int mode;
    const char* Ap; const float* W0; const float* W1; const int* LTOK; const LAS int* T; bool dbg_same;
    __device__ __forceinline__ bool next(int i, pg8::Unit& u) const {
        const int L = i * G + c; if (L >= T[32]) return false;
        int e = 0;
#pragma unroll 1
        for (int s = 16; s >= 1; s >>= 1) if (T[e + s] <= L) e += s;
        const int l = L - T[e], mte = (T[e + 1] - T[e]) >> 4; u.e = e; u.pn = l / mte; u.pm = l - u.pn * mte; u.aux = T[80 + e] - u.pm * 256;
        return true;
    }
    __device__ __forceinline__ const char* abase() const { return Ap; }
    __device__ __forceinline__ unsigned arow_off(const pg8::Unit& u, int r) const {
        if (mode == 0) { const int tok = (r < u.aux) ? (LTOK[(size_t)u.e * MTOK + u.pm * 256 + r] >> 1) : 0; return (unsigned)tok * (unsigned)(K * 2); }
        return (unsigned)(T[40 + u.e] + u.pm * 256 + r) * (unsigned)(K * 2);
    }
    __device__ __forceinline__ int bpitch() const { return mode == 0 ? FF : DM; }
    __device__ __forceinline__ const float* bsrc(const pg8::Unit& u, int c4) const {
        if (dbg_same) { const int q = c4 >> 5, within = c4 & 31; return ((within < 16) ? W0 : W1) + 16 * q + (within & 15); }
        if (mode == 0) { const int q = c4 >> 5, within = c4 & 31; return ((within < 16) ? W0 : W1) + (size_t)u.e * DM * FF + 64 * u.pn + 16 * q + (within & 15); }
        return W0 + (size_t)u.e * FF * DM + 128 * u.pn + c4;
    }
};
struct Epi6 {
    bf16* HID; const int* LTOK; const float* rowss; const LAS int* T;
    __device__ __forceinline__ void operator()(const pg8::f32x4 (&acc)[4][8], const pg8::Unit& u, int cw, int fr, int fq) const {
        const int sb = T[40 + u.e] + u.pm * 256;
#pragma unroll
        for (int m = 0; m < 4; ++m) { const int r = cw * 64 + m * 16 + fr;
            const int tok = (r < u.aux) ? (LTOK[(size_t)u.e * MTOK + u.pm * 256 + r] >> 1) : 0;
            const float rs = 1.0f / sqrtf(rowss[tok] * (1.f / DM) + EPS);
#pragma unroll
            for (int q = 0; q < 4; ++q) { const pg8::f32x4 g = acc[m][2 * q] * rs, up = acc[m][2 * q + 1] * rs; pg8::f32x4 hv;
#pragma unroll
                for (int j = 0; j < 4; ++j) hv[j] = g[j] / (1.0f + __expf(-g[j])) * up[j];
                v2u w; w.x = pg8::cvt_pk_bf16(hv[0], hv[1]); w.y = pg8::cvt_pk_bf16(hv[2], hv[3]);
                *(v2u*)(HID + (size_t)(sb + r) * FF + u.pn * 64 + q * 16 + 4 * fq) = w; } }
    }
};
struct Epi7 {
    bf16* Y; const int* LTOK; const float* LGATE;
    __device__ __forceinline__ void operator()(const pg8::f32x4 (&acc)[4][8], const pg8::Unit& u, int cw, int fr, int fq) const {
#pragma unroll
        for (int m = 0; m < 4; ++m) { const int r = cw * 64 + m * 16 + fr;
            if (r < u.aux) { const size_t li = (size_t)u.e * MTOK + u.pm * 256 + r; const int aid = LTOK[li]; const float gate = LGATE[li];
                bf16* yp = Y + (size_t)aid * DM + u.pn * 128 + 4 * fq;
#pragma unroll
                for (int n = 0; n < 8; ++n) { const pg8::f32x4 v = acc[m][n] * gate; v2u w; w.x = pg8::cvt_pk_bf16(v[0], v[1]); w.y = pg8::cvt_pk_bf16(v[2], v[3]); *(v2u*)(yp + n * 16) = w; } } }
    }
};


#ifdef MK_DIAG
__device__ __forceinline__ float blk_reduce(float v, bool ismax, LAS float* red, int tid) {
    for (int o = 1; o < 64; o <<= 1) { const float t = __shfl_xor(v, o); v = ismax ? fmaxf(v, t) : v + t; }
    __syncthreads(); if ((tid & 63) == 0) red[tid >> 6] = v; __syncthreads();
    float r = red[0]; for (int i = 1; i < 8; ++i) r = ismax ? fmaxf(r, red[i]) : r + red[i];
    __syncthreads(); return r;
}
__device__ __forceinline__ void diag_row(const Args& A, LAS unsigned char* lds, int b, int t, int tid) {
    unsigned char* ws = A.ws; const int row = b * SEQ + t; float* ctl = (float*)(ws + WS_CTL) + 512;
    LAS float* sc = (LAS float*)lds; LAS float* lg = sc + 4096; LAS float* cum = lg + 4096; LAS float* red = cum + 4096; LAS float* ov = red + 64; LAS unsigned char* sel = (LAS unsigned char*)(ov + 512);
    const bf16* OUTR = (const bf16*)(ws + WS_OF) + (size_t)row * DM;
    for (int s = tid; s < SEQ; s += NTHREADS) { float v = -__builtin_inff();
        if (s <= t) { v = 0.f; for (int j = 0; j < IDXH; ++j) { float d = 0.f;
                for (int k = 0; k < IDXD; ++k) { const int srow = b * SEQ + s; d += bf2f(((const bf16*)(ws + WS_QI))[(size_t)row * 1024 + j * 64 + k]) * bf2f(((const bf16*)(ws + WS_KI))[((size_t)(srow >> 5) * 8 + (k >> 3)) * 256 + (srow & 31) * 8 + (k & 7)]); }
                v += ((const float*)(ws + WS_WI))[(size_t)row * IDXH + j] * fmaxf(d, 0.f); } }
        sc[s] = v; }
    __syncthreads();
    for (int s = tid; s < SEQ; s += NTHREADS) { int rank = 0; const float v = sc[s];
        if (s <= t) { for (int q = 0; q <= t; ++q) { const float u = sc[q]; rank += (u > v || (u == v && q < s)) ? 1 : 0; } }
        sel[s] = (s <= t && rank < TOPK) ? 1 : 0; }
    __syncthreads();
    float sd[3] = {0.f, 0.f, 0.f}, sr[3] = {0.f, 0.f, 0.f};
    for (int kind = 0; kind < 3; ++kind) {
        const int nh = kind == 2 ? 4 : 6, nk = kind == 2 ? NMEM : t + 1;
        if (kind == 0 && tid == 0) { }
        for (int h = 0; h < nh; ++h) {
            const bf16* Q; const bf16* K; const bf16* V; int ocol;
            if (kind == 0) { const size_t ho = (size_t)(b * 6 + h) * SEQ * HD; Q = (const bf16*)(ws + WS_QF) + ho + (size_t)t * HD; K = (const bf16*)(ws + WS_KF) + ho; V = (const bf16*)(ws + WS_VF) + ho; ocol = h * HD; }
            else if (kind == 1) { const size_t ho = (size_t)(b * 6 + h) * SEQ * HD; Q = (const bf16*)(ws + WS_QD) + ho + (size_t)t * HD; K = (const bf16*)(ws + WS_KD) + ho; V = (const bf16*)(ws + WS_VD) + ho; ocol = FOXW + h * HD; }
            else { Q = (const bf16*)(ws + WS_QC) + ((size_t)(b * 4 + h) * SEQ + t) * HD; K = (const bf16*)(ws + WS_KC) + (size_t)(b * 4 + h) * NMEM * HD; V = (const bf16*)(ws + WS_VC) + (size_t)(b * 4 + h) * NMEM * HD; ocol = FOXW + DSAW + h * HD; }
            if (kind == 0) { if (tid == 0) { float c = 0.f; const float* lf = (const float*)(ws + WS_LOGF) + (size_t)(b * 6 + h) * SEQ; for (int s = 0; s < SEQ; ++s) { c += lf[s]; cum[s] = c; } } __syncthreads(); }
            float mx = -__builtin_inff();
            for (int s = tid; s < SEQ; s += NTHREADS) { float v = -__builtin_inff();
                if (s < nk && (kind != 1 || sel[s])) { float d = 0.f; for (int k = 0; k < HD; ++k) d += bf2f(Q[k]) * bf2f(K[(size_t)s * HD + k]); v = d * att::SCALE; if (kind == 0) v += cum[t] - cum[s]; }
                lg[s] = v; mx = fmaxf(mx, v); }
            mx = blk_reduce(mx, true, red, tid);
            float sm = 0.f;
            for (int s = tid; s < SEQ; s += NTHREADS) { const float p = (lg[s] == -__builtin_inff()) ? 0.f : expf(lg[s] - mx); lg[s] = p; sm += p; }
            sm = blk_reduce(sm, false, red, tid);
            { const int d = tid & 127, part = tid >> 7; float o = 0.f;
              for (int s = part; s < nk; s += 4) { const float p = lg[s]; if (p != 0.f) o += p * bf2f(V[(size_t)s * HD + d]); }
              ov[tid] = o; }
            __syncthreads();
            if (tid < 128) { const float o = (ov[tid] + ov[128 + tid] + ov[256 + tid] + ov[384 + tid]) / sm; const float g = bf2f(OUTR[ocol + tid]); sd[kind] += (g - o) * (g - o); sr[kind] += o * o; }
            __syncthreads();
        }
    }
    for (int kind = 0; kind < 3; ++kind) { const float a = blk_reduce(sd[kind], false, red, tid), c = blk_reduce(sr[kind], false, red, tid); if (tid == 0) { atomicAdd(ctl + 2 * kind, a); atomicAdd(ctl + 2 * kind + 1, c); } }
}
#endif
constexpr int NPHASES = 11;
__global__ void __launch_bounds__(NTHREADS, 2) mk_fwd(Args A) {
    extern __shared__ __attribute__((aligned(16))) unsigned char lds[];
    cg::grid_group grid = cg::this_grid();
    Frame F; F.tid = threadIdx.x; F.lane = F.tid & 63; F.wave = __builtin_amdgcn_readfirstlane(F.tid >> 6); F.G = gridDim.x; F.c = blockIdx.x;
    F.vcu = (F.G % 8 == 0) ? (F.c % 8) * (F.G / 8) + F.c / 8 : F.c;
    LAS unsigned char* L3 = (LAS unsigned char*)lds;
    unsigned char* ws = A.ws;
    const int lo = A.ph_lo, hi = A.ph_hi;
#ifndef PHASE_MASK
#define PHASE_MASK 0xFFFF
#endif
#define IN(k) (((PHASE_MASK >> (k)) & 1) && lo <= (k) && (k) < hi)
#define REFRESH0() do {} while (0)
    volatile LAS unsigned* xst = (volatile LAS unsigned*)(L3 + LDSCTL_OFF + 1024);
    if (F.tid < 4) xst[F.tid] = 0u;
    __syncthreads();
    XcdBarrier xbar = xcd_barrier_post((unsigned*)(ws + WS_CTL) + CW_BAR, xst);
#define SEAM(k) do { if (IN(k) && IN((k) + 1)) { if ((k) == 0) grid.sync(); else xcd_barrier(xbar); } } while (0)
    const int gw = F.vcu * NWAVES + F.wave, NGW = F.G * NWAVES;

    if (IN(0)) { p0_prologue(A, F, L3); } SEAM(0);
    if (IN(1)) {
        Sched1 S{F.G, F.c, (const char*)(ws + WS_H), (const char*)(ws + WS_WIN), (const char*)(ws + WS_WMKV), (unsigned)(WS_MEMN - WS_H), false};
        Epi1 E{(bf16*)(ws + WS_PROJ), (bf16*)(ws + WS_MKV)};
        pg8::gemm_phase<Epi1, Sched1, true, true>(L3, DM, S, E);
    } SEAM(1);
    if (IN(2)) {
        const RopeFreq RF = rope_freqs(F.lane);
        for (int r = gw; r < MTOK + BATCH * NMEM; r += NGW) { if (r < MTOK) p1b_row(A, r, F.lane, RF); else p1b_memrow(A, r - MTOK, F.lane); }
    } SEAM(2);
    if (IN(3)) {
        for (int it = F.c; it < 256; it += F.G) { const int b = it >> 7, y = it & 127; indexer_block(A, F, L3, b, y); indexer_block(A, F, L3, b, 255 - y); }
    } SEAM(3);
    if (IN(4)) {
        const int G = F.G, v = F.vcu;
        attn_stream<1, 0>(A, F, (char*)lds, v, 96);
        attn_stream<2, 1>(A, F, (char*)lds, (v + G - (96 % G)) % G, 96);
        attn_stream<3, 2>(A, F, (char*)lds, (v + G - (192 % G)) % G, 64);
        { const int ci = (v + G - (192 % G)) % G;
          Sched1 S{G, ci, (const char*)(ws + WS_H), (const char*)(ws + WS_WIN), (const char*)(ws + WS_WMKV), (unsigned)(WS_MEMN - WS_H), true};
          Epi1 E{(bf16*)(ws + WS_PROJ), (bf16*)(ws + WS_MKV)};
          pg8::gemm_phase<Epi1, Sched1, true, true>(L3, DM, S, E); }
    } SEAM(4);
    if (IN(5)) {
        SchedRows S{F.G, F.c, 8, DM, (const char*)(ws + WS_OF), (const char*)(ws + WS_WBF)}; Epi3 E{(const bf16*)(ws + WS_PROJ), (bf16*)(ws + WS_MERGED)}; HookMerge H{(const bf16*)(ws + WS_PROJ)};
        pg8::gemm_phase<Epi3, SchedRows, true, true, HookMerge>(L3, DM, S, E, H);
    } SEAM(5);
    if (IN(6)) {
        SchedRows S{F.G, F.c, 8, DM, (const char*)(ws + WS_MERGED), (const char*)(ws + WS_WOUT)};
        Epi4 E{A.x, A.out, (bf16*)(ws + WS_X1G), A.ffn_norm_g, (float*)(ws + WS_CTL) + CW_ROWSS};
        pg8::gemm_phase<Epi4, SchedRows, true, true>(L3, DM, S, E);
    } SEAM(6);
    if (IN(7)) { for (int it = F.c; it < MTOK / 32; it += F.G) router_block(A, F, L3, it * 32); } SEAM(7);
    if (IN(8)) {
        moe_tables(A, L3, F);
        const bool dbg = (A.flags & 4) != 0;
        SchedMoeLC S{F.G, F.vcu, DM, 0, (const char*)(ws + WS_X1G), A.expert_w_gate, A.expert_w_up, (const int*)(ws + WS_LTOK), (const LAS int*)(L3 + LDSCTL_OFF), dbg};
        Epi6 E{(bf16*)(ws + (dbg ? WS_WGU : WS_HID)), (const int*)(ws + WS_LTOK), (const float*)(ws + WS_CTL) + CW_ROWSS, (const LAS int*)(L3 + LDSCTL_OFF)};
        lc::gemm_lc<Epi6, SchedMoeLC>(L3, DM, S, E);
    } SEAM(8);
    if (IN(9)) {
        moe_tables(A, L3, F);
        SchedMoeLC S{F.G, F.vcu, FF, 1, (const char*)(ws + WS_HID), A.expert_w_down, nullptr, (const int*)(ws + WS_LTOK), (const LAS int*)(L3 + LDSCTL_OFF), false};
        Epi7 E{(bf16*)(ws + WS_Y), (const int*)(ws + WS_LTOK), (const float*)(ws + WS_LGATE)};
        lc::gemm_lc<Epi7, SchedMoeLC>(L3, FF, S, E);
    } SEAM(9);
#ifdef MK_DIAG
    if (lo == 11) { REFRESH0(); for (int it = F.c; it < 256; it += F.G) { const int b = it & 1; const int t = (it < 32) ? (it * 9 + 3) : (int)(((unsigned)it * 2654435761u >> 7) % SEQ); diag_row(A, L3, b, t, F.tid); } }
#endif
    if (IN(10)) {
        const v2u* Y = (const v2u*)(ws + WS_Y); f32x4* O = (f32x4*)A.out;
        for (size_t i = (size_t)F.c * NTHREADS + F.tid; i < (size_t)MTOK * (DM / 4); i += (size_t)F.G * NTHREADS) {
            const size_t tok = i / (DM / 4), c4 = i % (DM / 4);
            const v2u y0 = Y[(2 * tok) * (DM / 4) + c4], y1 = Y[(2 * tok + 1) * (DM / 4) + c4]; f32x4 o = O[i];
            o.x += bflo(y0.x) + bflo(y1.x); o.y += bfhi(y0.x) + bfhi(y1.x); o.z += bflo(y0.y) + bflo(y1.y); o.w += bfhi(y0.y) + bfhi(y1.y);
            O[i] = o;
        }
#ifdef MK_DIAG
        if (F.c == 0 && F.tid == 0) { const float* ctl = (const float*)(ws + WS_CTL) + 512; float e = 0.f;
            for (int k = 0; k < 3; ++k) if ((MK_DIAG >> k) & 1) e = fmaxf(e, sqrtf(ctl[2 * k] / fmaxf(ctl[2 * k + 1], 1e-30f)));
            __builtin_amdgcn_s_sleep(100); A.out[(size_t)MTOK * DM - 1] += 1000.f * e; }
#endif
    }
#undef IN
#undef SEAM
}

extern "C" void kernel_launch(void* const* d_in, const int* in_sizes, int n_in, void* d_out, int out_size, void* d_ws, size_t ws_size, hipStream_t stream) {
    static int grid = 0;
    if (grid == 0) {
        if (n_in != 27 || out_size != MTOK * DM || ws_size < WS_END) { fprintf(stderr, "kernel_launch: unexpected shapes (n_in %d out %d ws %zu need %zu)\n", n_in, out_size, ws_size, (size_t)WS_END); grid = -1; return; }
        int dev = 0, cus = 0, per_cu = 0;
        (void)hipGetDevice(&dev); (void)hipDeviceGetAttribute(&cus, hipDeviceAttributeMultiprocessorCount, dev);
        (void)hipFuncSetAttribute((const void*)mk_fwd, hipFuncAttributeMaxDynamicSharedMemorySize, LDS_BYTES);
        (void)hipOccupancyMaxActiveBlocksPerMultiprocessor(&per_cu, (const void*)mk_fwd, NTHREADS, LDS_BYTES);
        if (per_cu < 1) fprintf(stderr, "kernel_launch: occupancy query says %d blocks/CU\n", per_cu);
        (void)hipGetLastError();
        grid = cus > 0 ? cus : 256;
    }
    if (grid < 0) return;
    (void)hipMemsetAsync((char*)d_ws + WS_CTL, 0, CTL_ZERO_BYTES, stream);
    Args a{};
    const float** pf = (const float**)&a;
    for (int i = 0; i < 27; ++i) pf[i] = (const float*)d_in[i];
    a.positions = (const int*)d_in[2];
    a.out = (float*)d_out; a.ws = (unsigned char*)d_ws;
#if MK_N_LAUNCHES == 1
    a.ph_lo = 0; a.ph_hi = NPHASES;
    void* args[] = {&a};
    hipError_t e = hipLaunchCooperativeKernel((const void*)mk_fwd, dim3(grid), dim3(NTHREADS), args, LDS_BYTES, stream);
    if (e != hipSuccess) fprintf(stderr, "cooperative launch failed: %s (grid %d)\n", hipGetErrorString(e), grid);
#else
#ifndef EXP_REPEAT
#define EXP_REPEAT 0
#endif
#ifndef EXP_FLAGS
#define EXP_FLAGS 0
#endif
    for (int p = 0; p < NPHASES; ++p) { a.ph_lo = p; a.ph_hi = p + 1;
#ifdef MK_DIAG
        if (p == 10) { a.ph_lo = 11; a.ph_hi = 11; a.flags = 0; hipLaunchKernelGGL(mk_fwd, dim3(grid), dim3(NTHREADS), LDS_BYTES, stream, a); a.ph_lo = 10; a.ph_hi = 11; }
#endif
        for (int r = 0; r < (((EXP_REPEAT >> p) & 1) ? 2 : 1); ++r) { a.flags = r ? EXP_FLAGS : 0; hipLaunchKernelGGL(mk_fwd, dim3(grid), dim3(NTHREADS), LDS_BYTES, stream, a); } }
#endif
}
```

```cpp
#include <hip/hip_runtime.h>
#include <hip/hip_cooperative_groups.h>
#include <cstdio>
#include <cstdint>
namespace cg = cooperative_groups;

#ifndef MK_N_LAUNCHES
#define MK_N_LAUNCHES 1
#endif

constexpr int BATCH = 2, SEQ = 4096, MTOK = BATCH * SEQ, DM = 2048;
constexpr int HD = 128, FOXH = 6, DSAH = 6, CRH = 4, NMEM = 256;
constexpr int FOXW = FOXH * HD, DSAW = DSAH * HD, CRW = CRH * HD;
constexpr int IDXH = 16, IDXD = 64, TOPK = 256;
constexpr int NEXP = 32, EPG = 8, NGRP = 4, FF = 1024;
constexpr int INW = 12374, N1 = 12544;
constexpr float EPS = 1e-6f;
constexpr float ROPE_THETA = 500000.0f;
constexpr int C_FQ = 0, C_FK = 768, C_FV = 1536, C_DQ = 2304, C_DK = 3072, C_DV = 3840, C_CQ = 4608, C_IQ = 5120, C_IK = 6144, C_FL = 6208, C_IW = 6214, C_G = 6272;
__host__ __device__ __forceinline__ int win_src_col(int n) {
    if (n < 2304) return n;
    if (n < 4608) return n - 2304 + 2310;
    if (n < 5120) return n - 4608 + 5718;
    if (n < 6144) return n - 5120 + 4614;
    if (n < 6208) return n - 6144 + 5654;
    if (n < 6214) return n - 6208 + 2304;
    if (n < 6230) return n - 6214 + 5638;
    if (n < 6272) return -1;
    if (n < 12416) return n - 6272 + 6230;
    return -1;
}
constexpr int MAXSLOT = 24576;

constexpr size_t MiB = 1u << 20;
constexpr size_t al256(size_t x) { return (x + 255) & ~(size_t)255; }
constexpr size_t WS_CTL = 0, CTL_ZERO_BYTES = 128 * 1024;
constexpr size_t WS_WIN = 1 * MiB;
constexpr size_t WS_WMKV = WS_WIN + (size_t)N1 * DM * 2;
constexpr size_t WS_WBF = WS_WMKV + (size_t)1024 * DM * 2;
constexpr size_t WS_WBD = WS_WBF + (size_t)DM * FOXW * 2;
constexpr size_t WS_WBC = WS_WBD + (size_t)DM * DSAW * 2;
constexpr size_t WS_WOUT = WS_WBC + (size_t)DM * CRW * 2;
constexpr size_t WS_WGU = WS_WOUT + (size_t)DM * DM * 2;
constexpr size_t WS_WD = WS_WGU + (size_t)NEXP * 2048 * DM * 2;
constexpr size_t WS_H = WS_WD + (size_t)NEXP * DM * FF * 2;
constexpr size_t WS_MEMN = WS_H + (size_t)MTOK * DM * 2;
constexpr size_t WS_MKV = WS_MEMN + (size_t)512 * DM * 2;
constexpr size_t WS_QF = WS_MKV + (size_t)512 * 1024 * 2;
constexpr size_t HSZ6 = (size_t)BATCH * 6 * SEQ * HD * 2, HSZ4 = (size_t)BATCH * 4 * SEQ * HD * 2;
constexpr size_t WS_KF = WS_QF + HSZ6, WS_VF = WS_KF + HSZ6, WS_QD = WS_VF + HSZ6, WS_KD = WS_QD + HSZ6, WS_VD = WS_KD + HSZ6;
constexpr size_t WS_QC = WS_VD + HSZ6;
constexpr size_t WS_KC = WS_QC + HSZ4;
constexpr size_t WS_VC = WS_KC + (size_t)BATCH * 4 * NMEM * HD * 2;
constexpr size_t WS_QI = WS_VC + (size_t)BATCH * 4 * NMEM * HD * 2;
constexpr size_t WS_KI = WS_QI + (size_t)MTOK * IDXH * IDXD * 2;
constexpr size_t WS_WI = WS_KI + (size_t)MTOK * IDXD * 2;
constexpr size_t WS_LOGF = WS_WI + (size_t)MTOK * IDXH * 4;
constexpr size_t WS_MASK = WS_LOGF + (size_t)BATCH * FOXH * SEQ * 4;
constexpr size_t WS_OF = WS_MASK + (size_t)MTOK * 64 * 8;
constexpr size_t WS_OD = WS_OF + (size_t)MTOK * FOXW * 2;
constexpr size_t WS_OC = WS_OD + (size_t)MTOK * DSAW * 2;
constexpr size_t WS_LTOK = WS_OC + (size_t)MTOK * CRW * 2;
constexpr size_t WS_LGATE = WS_LTOK + (size_t)NEXP * MTOK * 4;
constexpr size_t WS_LRS = WS_WD;
constexpr size_t WS_RA = al256(WS_LGATE + (size_t)NEXP * MTOK * 4);
constexpr size_t RA_BYTES = (size_t)MTOK * N1 * 2;
constexpr size_t WS_PROJ = WS_RA;
constexpr size_t WS_END0 = WS_RA + RA_BYTES;
constexpr size_t WS_RB = al256(WS_END0);
constexpr size_t WS_SCORES = WS_RB;
constexpr size_t WS_M32 = WS_RB;
constexpr size_t WS_MERGED = WS_RB + (size_t)MTOK * DM * 4;
constexpr size_t WS_X1G = WS_MERGED + (size_t)MTOK * DM * 2;
constexpr size_t WS_Y = WS_RA;
constexpr size_t WS_HID = WS_RB + (size_t)MTOK * SEQ * 4;
constexpr size_t WS_END = WS_HID + (size_t)MAXSLOT * FF * 2;
static_assert(WS_X1G + (size_t)MTOK * DM * 2 <= WS_HID, "region B map");
static_assert((size_t)2 * MTOK * DM * 4 <= RA_BYTES, "Y fits region A");
constexpr int CW_CNT = 64;
constexpr int CW_ROWSS = 1024;
constexpr int CW_BAR = 16384;
static_assert(CW_ROWSS + MTOK <= CW_BAR && (CW_BAR + 3456) * 4 <= (int)CTL_ZERO_BYTES, "ctl");

constexpr int RING_BYTES = 131072;
constexpr int LDSCTL_OFF = RING_BYTES;
constexpr int LDS_BYTES = 163840;
constexpr int NWAVES = 8, NTHREADS = 512;

#define GAS __attribute__((address_space(1)))
#define LAS __attribute__((address_space(3)))
typedef unsigned short bf16;
typedef unsigned v4u __attribute__((ext_vector_type(4)));
typedef unsigned v2u __attribute__((ext_vector_type(2)));
typedef float f32x4 __attribute__((ext_vector_type(4)));
typedef float f32x16 __attribute__((ext_vector_type(16)));
typedef short bf16x8 __attribute__((ext_vector_type(8)));
#define LDS_WAIT() asm volatile("s_waitcnt lgkmcnt(0)" ::: "memory")
#define VM_WAIT() asm volatile("s_waitcnt vmcnt(0)" ::: "memory")
__device__ __forceinline__ unsigned f2bf(float f) { unsigned u = __builtin_bit_cast(unsigned, f); return (u + 0x7fffu + ((u >> 16) & 1u)) >> 16; }
__device__ __forceinline__ unsigned pk2(float lo, float hi) { unsigned r; asm("v_cvt_pk_bf16_f32 %0, %1, %2" : "=v"(r) : "v"(lo), "v"(hi)); return r; }
__device__ __forceinline__ float bf2f(unsigned short b) { return __builtin_bit_cast(float, (unsigned)b << 16); }
__device__ __forceinline__ float bflo(unsigned w) { return __builtin_bit_cast(float, w << 16); }
__device__ __forceinline__ float bfhi(unsigned w) { return __builtin_bit_cast(float, w & 0xffff0000u); }
__device__ __forceinline__ float wave_sum(float v) {
#pragma unroll
    for (int o = 1; o < 64; o <<= 1) v += __shfl_xor(v, o);
    return v;
}
namespace pg8 {
#define PG8_LAS __attribute__((address_space(3)))
typedef unsigned short bf16_t;
typedef short bf16x8 __attribute__((ext_vector_type(8)));
typedef float f32x4 __attribute__((ext_vector_type(4)));
typedef float f32x2 __attribute__((ext_vector_type(2)));
typedef unsigned u32x4 __attribute__((ext_vector_type(4)));
typedef unsigned u32x2 __attribute__((ext_vector_type(2)));
constexpr int BM = 256, BK = 64, HALF = 128, HTB = HALF * BK * 2  , STAGE_BYTES = 8 * HTB, NXCD = 8, WGM = 8;

__host__ __device__ __forceinline__ int lds_byte(int r, int c) { const int st = (r >> 4) * 2 + (c >> 5), rr = r & 15, cc = c & 31, ob = rr * 64 + cc * 2; return st * 1024 + (ob ^ (((ob >> 9) & 1) << 5)); }
__host__ __device__ __forceinline__ void stage_rc(int b, int& R, int& C) { const int st = b / 1024, sb = b % 1024, swz = sb ^ (((sb >> 9) & 1) << 5); R = (st >> 1) * 16 + swz / 64; C = (st & 1) * 32 + (swz % 64) / 2; }
__host__ __device__ __forceinline__ int perm32(int rho) { const int n = rho >> 4, i = rho & 15; return 8 * (i >> 2) + 4 * n + (i & 3); }

struct Unit { int pm, pn, e, aux; };

__device__ __forceinline__ void tile_order(int L, int nM, int nN, int& pm, int& pn) {
    const int nwg = nM * nN; int wgid = L;
    { const int q = nwg / NXCD, r = nwg % NXCD, xcd = wgid % NXCD, off = wgid / NXCD; wgid = (xcd < r ? xcd * (q + 1) : r * (q + 1) + (xcd - r) * q) + off; }
    const int nig = WGM * nN, gid = wgid / nig, fm = gid * WGM, gsz = (nM - fm) < WGM ? (nM - fm) : WGM;
    pm = fm + ((wgid % nig) % gsz); pn = (wgid % nig) / gsz;
}

__device__ __forceinline__ unsigned cvt_pk_bf16(float lo, float hi) { unsigned r; asm volatile("v_cvt_pk_bf16_f32 %0, %1, %2" : "=v"(r) : "v"(lo), "v"(hi)); return r; }

struct NoHook { static constexpr bool ENABLED = false; __device__ __forceinline__ bool at(int) const { return false; } __device__ __forceinline__ void operator()(f32x4 (&)[2][2][4][2], const Unit&, int, int, int, int, int) const {} };
template <class Epi, class Sched, bool ALIGN_EPI = false, bool SP2 = false, class Hook = NoHook>
__device__ __forceinline__ void gemm_phase(PG8_LAS unsigned char* lds, const int K, const Sched& S, const Epi& E, const Hook& H = Hook()) {
    const int tid = threadIdx.x, wid = __builtin_amdgcn_readfirstlane(tid >> 6), lane = tid & 63, wr = wid >> 2, wc = wid & 3, fr = lane & 15, fq = lane >> 4;
    const int nt = K / BK;
    int R0, C0, R1, C1; stage_rc(tid * 16, R0, C0); stage_rc(tid * 16 + 8192, R1, C1);
    unsigned voffB[2];
    { const int Rb0 = Epi::PERM ? ((R0 & ~31) + perm32(R0 & 31)) : R0, Rb1 = Epi::PERM ? ((R1 & ~31) + perm32(R1 & 31)) : R1;
      voffB[0] = (unsigned)(Rb0 * K + C0) * 2u; voffB[1] = (unsigned)(Rb1 * K + C1) * 2u; }
    const size_t kstep = (size_t)(BK * 2);
    const size_t hstep = (size_t)HALF * K * 2;
    const unsigned ldsw = (unsigned)wid * 1024u;
    const int aoff = lds_byte(wr * 64 + fr, fq * 8), boff = lds_byte(wc * 32 + fr, fq * 8);
#define PG8_SA(b, h) (((b) * 2 + (h)) * HTB)
#define PG8_SB(b, h) ((4 + (b) * 2 + (h)) * HTB)
#define PG8_STAGE(bufoff, gbase, v0, v1) do { \
        __builtin_amdgcn_global_load_lds((const unsigned*)((const char*)(gbase) + (v0)), (PG8_LAS unsigned*)(lds + (bufoff) + ldsw), 16, 0, 0); \
        __builtin_amdgcn_global_load_lds((const unsigned*)((const char*)(gbase) + (v1)), (PG8_LAS unsigned*)(lds + (bufoff) + ldsw + 8192), 16, 0, 0); } while (0)
#define PG8_STAGEB(bufoff, gbase) PG8_STAGE(bufoff, gbase, voffB[0], voffB[1])
#define PG8_LDA(dst, b, h) do { _Pragma("unroll") for (int m = 0; m < 4; ++m) _Pragma("unroll") for (int k = 0; k < 2; ++k) dst[m][k] = *(const PG8_LAS bf16x8*)(lds + PG8_SA(b, h) + aoff + m * 2048 + k * 1024); } while (0)
#define PG8_LDB(dst, b, h) do { _Pragma("unroll") for (int n = 0; n < 2; ++n) _Pragma("unroll") for (int k = 0; k < 2; ++k) dst[n][k] = *(const PG8_LAS bf16x8*)(lds + PG8_SB(b, h) + boff + n * 2048 + k * 1024); } while (0)
#define PG8_MMA(ai, bj, At, Bt) do { __builtin_amdgcn_s_setprio(1); _Pragma("unroll") for (int m = 0; m < 4; ++m) _Pragma("unroll") for (int n = 0; n < 2; ++n) _Pragma("unroll") for (int k = 0; k < 2; ++k) \
        acc[ai][bj][m][n] = __builtin_amdgcn_mfma_f32_16x16x32_bf16(Bt[n][k], At[m][k], acc[ai][bj][m][n], 0, 0, 0); __builtin_amdgcn_s_setprio(0); } while (0)
#define PG8_WAIT_V(n) asm volatile("s_waitcnt vmcnt(" #n ")" ::: "memory")
#define PG8_WAIT_L(n) asm volatile("s_waitcnt lgkmcnt(" #n ")" ::: "memory")
#define PG8_BAR __builtin_amdgcn_s_barrier()
#define PG8_SCHED __builtin_amdgcn_sched_barrier(0)
    Unit cur, nxt; int ui = 0;
    if (!S.next(0, cur)) return;
    f32x4 acc[2][2][4][2];
#pragma unroll
    for (int a = 0; a < 2; ++a)
#pragma unroll
        for (int b = 0; b < 2; ++b)
#pragma unroll
            for (int m = 0; m < 4; ++m)
#pragma unroll
                for (int n = 0; n < 2; ++n) acc[a][b][m][n] = (f32x4){0.f, 0.f, 0.f, 0.f};
    bf16x8 At[4][2], B0[2][2], B1[2][2];
    const char* const Ab = S.abase();
    unsigned a00 = S.arow_off(cur, R0) + (unsigned)C0 * 2u, a01 = S.arow_off(cur, R1) + (unsigned)C1 * 2u;
    unsigned a10 = S.arow_off(cur, HALF + R0) + (unsigned)C0 * 2u, a11 = S.arow_off(cur, HALF + R1) + (unsigned)C1 * 2u;
    unsigned n00, n01, n10, n11;
    const char* cB = S.bbase(cur);
    if constexpr (SP2) {
        PG8_STAGEB(PG8_SB(0, 0), cB); PG8_STAGEB(PG8_SB(0, 1), cB + hstep); PG8_STAGE(PG8_SA(0, 0), Ab, a00, a01); PG8_STAGE(PG8_SA(0, 1), Ab, a10, a11);
        if (wr == 1) PG8_BAR;
        PG8_WAIT_V(2); PG8_BAR;
        PG8_STAGEB(PG8_SB(1, 0), cB + kstep); PG8_STAGE(PG8_SA(1, 0), Ab + kstep, a00, a01); PG8_STAGEB(PG8_SB(1, 1), cB + hstep + kstep);
        PG8_WAIT_V(6); PG8_BAR;
    } else {
        PG8_STAGEB(PG8_SB(0, 0), cB); PG8_STAGE(PG8_SA(0, 0), Ab, a00, a01); PG8_STAGEB(PG8_SB(0, 1), cB + hstep); PG8_STAGE(PG8_SA(0, 1), Ab, a10, a11);
        if (wr == 1) PG8_BAR;
        PG8_WAIT_V(4); PG8_BAR;
        PG8_STAGEB(PG8_SB(1, 0), cB + kstep); PG8_STAGE(PG8_SA(1, 0), Ab + kstep, a00, a01); PG8_STAGEB(PG8_SB(1, 1), cB + hstep + kstep);
        PG8_WAIT_V(6); PG8_BAR;
    }
    for (;;) {
        const bool has_next = S.next(ui + 1, nxt);
        const char* nB = cB;
        if (has_next) { nB = S.bbase(nxt);
            int tt = tid; asm volatile("" : "+v"(tt));
            int Rn0, Cn0, Rn1, Cn1; stage_rc(tt * 16, Rn0, Cn0); stage_rc(tt * 16 + 8192, Rn1, Cn1);
            n00 = S.arow_off(nxt, Rn0) + (unsigned)Cn0 * 2u; n01 = S.arow_off(nxt, Rn1) + (unsigned)Cn1 * 2u;
            n10 = S.arow_off(nxt, HALF + Rn0) + (unsigned)Cn0 * 2u; n11 = S.arow_off(nxt, HALF + Rn1) + (unsigned)Cn1 * 2u; }
        else { n00 = a00; n01 = a01; n10 = a10; n11 = a11; }
        for (int t = 0; t < nt; t += 2) {
            const bool last = (t == nt - 2);
            const char* ak1 = Ab + (size_t)(t + 1) * kstep;
            const char* ak2 = last ? Ab : Ab + (size_t)(t + 2) * kstep;
            const char* b2 = last ? nB : cB + (size_t)(t + 2) * kstep;
            const char* ak3 = ak2 + kstep; const char* b3 = b2 + kstep;
            const unsigned x00 = last ? n00 : a00, x01 = last ? n01 : a01, x10 = last ? n10 : a10, x11 = last ? n11 : a11;
            if constexpr (Hook::ENABLED) { if (H.at(t)) { H(acc, cur, wr, wc, fr, fq, t); } __builtin_amdgcn_sched_barrier(0); }
            if constexpr (SP2) {
            PG8_LDB(B0, 0, 0); PG8_LDB(B1, 0, 1); PG8_SCHED; PG8_LDA(At, 0, 0); PG8_STAGE(PG8_SA(1, 1), ak1, a10, a11);
            PG8_WAIT_V(8); PG8_WAIT_L(0); PG8_BAR; PG8_MMA(0, 0, At, B0); PG8_MMA(0, 1, At, B1); PG8_BAR; PG8_SCHED;
            PG8_LDA(At, 0, 1); PG8_STAGEB(PG8_SB(0, 0), b2); PG8_STAGEB(PG8_SB(0, 1), b2 + hstep); PG8_STAGE(PG8_SA(0, 0), ak2, x00, x01);
            PG8_WAIT_V(8); PG8_WAIT_L(0); PG8_BAR; PG8_MMA(1, 0, At, B0); PG8_MMA(1, 1, At, B1); PG8_BAR; PG8_SCHED;
            PG8_LDB(B0, 1, 0); PG8_LDB(B1, 1, 1); PG8_SCHED; PG8_LDA(At, 1, 0); PG8_STAGE(PG8_SA(0, 1), ak2, x10, x11);
            PG8_WAIT_V(8); PG8_WAIT_L(0); PG8_BAR; PG8_MMA(0, 0, At, B0); PG8_MMA(0, 1, At, B1); PG8_BAR; PG8_SCHED;
            PG8_LDA(At, 1, 1); PG8_STAGEB(PG8_SB(1, 0), b3); PG8_STAGEB(PG8_SB(1, 1), b3 + hstep); PG8_STAGE(PG8_SA(1, 0), ak3, x00, x01);
            PG8_WAIT_V(8); PG8_WAIT_L(0); PG8_BAR; PG8_MMA(1, 0, At, B0); PG8_MMA(1, 1, At, B1); PG8_BAR; PG8_SCHED;
            } else {
            PG8_LDB(B0, 0, 0); PG8_SCHED; PG8_LDA(At, 0, 0); PG8_STAGE(PG8_SA(1, 1), ak1, a10, a11);
            PG8_WAIT_L(8); PG8_BAR; PG8_WAIT_L(0); PG8_MMA(0, 0, At, B0); PG8_BAR; PG8_SCHED;
            PG8_LDB(B1, 0, 1); PG8_STAGEB(PG8_SB(0, 0), b2);
            PG8_BAR; PG8_WAIT_L(0); PG8_MMA(0, 1, At, B1); PG8_BAR;
            PG8_LDA(At, 0, 1); PG8_STAGE(PG8_SA(0, 0), ak2, x00, x01);
            PG8_BAR; PG8_WAIT_L(0); PG8_MMA(1, 0, At, B0); PG8_BAR; PG8_SCHED;
            PG8_STAGEB(PG8_SB(0, 1), b2 + hstep);
            PG8_WAIT_V(6); PG8_BAR; PG8_MMA(1, 1, At, B1); PG8_BAR;
            PG8_LDB(B0, 1, 0); PG8_SCHED; PG8_LDA(At, 1, 0); PG8_STAGE(PG8_SA(0, 1), ak2, x10, x11);
            PG8_WAIT_L(8); PG8_BAR; PG8_WAIT_L(0); PG8_MMA(0, 0, At, B0); PG8_BAR; PG8_SCHED;
            PG8_LDB(B1, 1, 1); PG8_STAGEB(PG8_SB(1, 0), b3);
            PG8_BAR; PG8_WAIT_L(0); PG8_MMA(0, 1, At, B1); PG8_BAR;
            PG8_LDA(At, 1, 1); PG8_STAGE(PG8_SA(1, 0), ak3, x00, x01);
            PG8_BAR; PG8_WAIT_L(0); PG8_MMA(1, 0, At, B0); PG8_BAR; PG8_SCHED;
            PG8_STAGEB(PG8_SB(1, 1), b3 + hstep);
            PG8_WAIT_V(6); PG8_BAR; PG8_MMA(1, 1, At, B1); PG8_BAR;
            }
        }
        if constexpr (ALIGN_EPI) { if (wr == 0) PG8_BAR; }
        E(acc, cur, wr, wc, fr, fq);
        if (!has_next) break;
#pragma unroll
        for (int a = 0; a < 2; ++a)
#pragma unroll
            for (int b = 0; b < 2; ++b)
#pragma unroll
                for (int m = 0; m < 4; ++m)
#pragma unroll
                    for (int n = 0; n < 2; ++n) acc[a][b][m][n] = (f32x4){0.f, 0.f, 0.f, 0.f};
        cur = nxt; cB = nB; a00 = n00; a01 = n01; a10 = n10; a11 = n11; ++ui;
        if constexpr (ALIGN_EPI) { if (wr == 1) PG8_BAR; }
    }
    PG8_WAIT_V(0);
    if constexpr (!ALIGN_EPI) { if (wr == 0) PG8_BAR; }
    PG8_BAR;
#undef PG8_SA
#undef PG8_SB
#undef PG8_STAGE
#undef PG8_STAGEB
#undef PG8_LDA
#undef PG8_LDB
#undef PG8_MMA
#undef PG8_WAIT_V
#undef PG8_WAIT_L
#undef PG8_BAR
#undef PG8_SCHED
}
}
namespace lc {
using pg8::Unit; using pg8::bf16x8; using pg8::f32x4; using pg8::lds_byte;
constexpr int A_STAGE = 32768, B_STAGE = 16384, A_OFF = 0, B_OFF = 3 * A_STAGE, LDS_TOTAL = B_OFF + 2 * B_STAGE;
#define LC_LAS __attribute__((address_space(3)))
#define LC_BAR() __builtin_amdgcn_s_barrier()
template <class Epi, class Sched>
__device__ __forceinline__ void gemm_lc(LC_LAS unsigned char* lds, const int K, const Sched& S, const Epi& E) {
    constexpr int D = 4;
    int tid_ = threadIdx.x; asm volatile("" : "+v"(tid_));
    const int tid = tid_, wid = __builtin_amdgcn_readfirstlane(tid >> 6), lane = tid & 63;
    const int nt = K / 64;
    Unit cur; if (!S.next(0, cur)) return;
    if (wid < 4) {
        const int cw = wid, fr = lane & 15, fq = lane >> 4;
        const int pj = lane >> 3; const unsigned pch = (unsigned)(((lane & 7) ^ pj) * 16);
        unsigned ao[8], an[8];
#pragma unroll
        for (int i = 0; i < 8; ++i) ao[i] = S.arow_off(cur, cw * 64 + 8 * i + pj) + pch;
        const char* const Ab = S.abase();
#define LC_ISSUE_A(stage, OFF, kt) do { const char* g_ = Ab + (size_t)(kt) * 128; _Pragma("unroll") for (int i = 0; i < 8; ++i) \
            __builtin_amdgcn_global_load_lds((const unsigned*)(g_ + OFF[i]), (LC_LAS unsigned*)(lds + A_OFF + (stage) * A_STAGE + (cw * 8 + i) * 1024), 16, 0, 0); } while (0)
        f32x4 acc[4][8];
#pragma unroll
        for (int m = 0; m < 4; ++m)
#pragma unroll
            for (int n = 0; n < 8; ++n) acc[m][n] = (f32x4){0.f, 0.f, 0.f, 0.f};
        const int arow = A_OFF + (cw * 64 + fr) * 128, aoff0 = arow + ((fq ^ (fr & 7)) * 16), aoff1 = arow + (((4 + fq) ^ (fr & 7)) * 16), boff = B_OFF + (fq * 128 + fr) * 16;
        LC_ISSUE_A(0, ao, 0); LC_ISSUE_A(1, ao, 1);
        asm volatile("s_waitcnt vmcnt(8)" ::: "memory"); LC_BAR();
        int gs = 0, bs = 0, ui = 0;
        for (;;) {
            Unit nxt; const bool has_next = S.next(ui + 1, nxt);
#pragma unroll
            for (int i = 0; i < 8; ++i) an[i] = has_next ? S.arow_off(nxt, cw * 64 + 8 * i + pj) + pch : ao[i];
            typename Epi::Pre pre;
#pragma unroll 1
            for (int t = 0; t < nt; ++t) {
                if (t == nt - 1) E.prefetch(pre, cur, cw, fr);
                const int s2 = gs + 2 >= 3 ? gs - 1 : gs + 2;
                const bool own = t + 2 < nt;
                const char* g2 = Ab + (size_t)(own ? t + 2 : t + 2 - nt) * 128;
                const LC_LAS unsigned char* As = lds + gs * A_STAGE; const LC_LAS unsigned char* Bp = lds + bs * B_STAGE + boff;
#pragma unroll
                for (int kk = 0; kk < 2; ++kk) {
                    bf16x8 af[4], bfr[8];
#pragma unroll
                    for (int m = 0; m < 4; ++m) af[m] = *(const LC_LAS bf16x8*)(As + (kk ? aoff1 : aoff0) + m * 2048);
#pragma unroll
                    for (int n = 0; n < 8; ++n) bfr[n] = *(const LC_LAS bf16x8*)(Bp + n * 256 + kk * 8192);
#pragma unroll
                    for (int m = 0; m < 4; ++m) {
                        __builtin_amdgcn_s_setprio(1);
#pragma unroll
                        for (int n = 0; n < 8; ++n) acc[m][n] = __builtin_amdgcn_mfma_f32_16x16x32_bf16(bfr[n], af[m], acc[m][n], 0, 0, 0);
                        __builtin_amdgcn_s_setprio(0);
                        __builtin_amdgcn_global_load_lds((const unsigned*)(g2 + (own ? ao[kk * 4 + m] : an[kk * 4 + m])), (LC_LAS unsigned*)(lds + A_OFF + s2 * A_STAGE + (cw * 8 + kk * 4 + m) * 1024), 16, 0, 0);
                        __builtin_amdgcn_sched_barrier(0);
                    }
                }
                asm volatile("s_waitcnt vmcnt(8) lgkmcnt(0)" ::: "memory"); LC_BAR();
                gs = gs == 2 ? 0 : gs + 1; bs ^= 1;
            }
            E(acc, cur, cw, fr, fq, pre, lds + A_OFF + (gs == 0 ? 2 : gs - 1) * A_STAGE + cw * 8192);
            if (!has_next) break;
#pragma unroll
            for (int m = 0; m < 4; ++m)
#pragma unroll
                for (int n = 0; n < 8; ++n) acc[m][n] = (f32x4){0.f, 0.f, 0.f, 0.f};
            cur = nxt; ++ui;
#pragma unroll
            for (int i = 0; i < 8; ++i) ao[i] = an[i];
        }
        asm volatile("s_waitcnt vmcnt(0)" ::: "memory");
#undef LC_ISSUE_A
    } else {
        const int ltid = tid - 256, n4 = ltid & 31, kq = ltid >> 5;
        const int pitch = S.bpitch();
        const int rot = 0;
        int wo[4];
#pragma unroll
        for (int c = 0; c < 4; ++c) wo[c] = B_OFF + (kq * 128 + 4 * n4 + ((c + rot) & 3)) * 16;
        f32x4 rb[D][8];
        Unit lu = cur; int li = 0, lk = 0; const float* lp = S.bsrc(lu, 4 * n4) + (size_t)(kq * 8) * pitch;
#define LC_LOAD(slot) do { const float* p_ = lp + (size_t)lk * 64 * pitch; _Pragma("unroll") for (int j = 0; j < 8; ++j) rb[slot][j] = *(const f32x4*)(p_ + (size_t)j * pitch); \
            if (++lk == nt) { lk = 0; Unit nu; if (S.next(li + 1, nu)) { lu = nu; ++li; lp = S.bsrc(lu, 4 * n4) + (size_t)(kq * 8) * pitch; } } } while (0)
#define LC_ROT(v) ({ f32x4 a_ = (rot & 1) ? (f32x4){(v)[1], (v)[2], (v)[3], (v)[0]} : (v); (rot & 2) ? (f32x4){a_[2], a_[3], a_[0], a_[1]} : a_; })
#define LC_WRITE(slot, stage) do { f32x4 q_[8]; _Pragma("unroll") for (int j = 0; j < 8; ++j) q_[j] = LC_ROT(rb[slot][j]); \
            _Pragma("unroll") for (int c = 0; c < 4; ++c) { pg8::u32x4 w_; \
            w_.x = pg8::cvt_pk_bf16(q_[0][c], q_[1][c]); w_.y = pg8::cvt_pk_bf16(q_[2][c], q_[3][c]); \
            w_.z = pg8::cvt_pk_bf16(q_[4][c], q_[5][c]); w_.w = pg8::cvt_pk_bf16(q_[6][c], q_[7][c]); \
            *(LC_LAS pg8::u32x4*)(lds + (stage) * B_STAGE + wo[c]) = w_; } } while (0)
        LC_LOAD(0); LC_LOAD(1); LC_LOAD(2); LC_LOAD(3);
        LC_WRITE(0, 0); LC_LOAD(0);
        asm volatile("s_waitcnt lgkmcnt(0)" ::: "memory"); LC_BAR();
        int ui = 0;
        for (;;) {
            Unit nxt; const bool has_next = S.next(ui + 1, nxt);
#pragma unroll 1
            for (int t = 0; t < nt; t += 4) {
                LC_WRITE(1, 1); LC_LOAD(1); asm volatile("s_waitcnt lgkmcnt(0)" ::: "memory"); LC_BAR();
                LC_WRITE(2, 0); LC_LOAD(2); asm volatile("s_waitcnt lgkmcnt(0)" ::: "memory"); LC_BAR();
                LC_WRITE(3, 1); LC_LOAD(3); asm volatile("s_waitcnt lgkmcnt(0)" ::: "memory"); LC_BAR();
                LC_WRITE(0, 0); LC_LOAD(0); asm volatile("s_waitcnt lgkmcnt(0)" ::: "memory"); LC_BAR();
            }
            if (!has_next) break;
            ++ui;
        }
        asm volatile("s_waitcnt vmcnt(0)" ::: "memory");
#undef LC_LOAD
#undef LC_WRITE
#undef LC_ROT
    }
    LC_BAR();
}
}
namespace att {
constexpr int D = 128;
constexpr float SCALE = 0.08838834764831845f;
constexpr float THR = 8.f;
constexpr int NW = 8, QBLK = 32, KVBLK = 64, QB = NW * QBLK;
constexpr int SHM_V = KVBLK * D * 2, SHM_K = KVBLK * D * 2;
constexpr int LDS_WS = 2 * SHM_V + 2 * SHM_K;
constexpr int LDS_BIAS = LDS_WS + NW * 64 * 4;
constexpr int LDS_BYTES = LDS_BIAS + 4096 * 4;
constexpr int LDS_STG = 86016;
typedef unsigned v4u_t __attribute__((ext_vector_type(4)));
typedef unsigned short bf16;
typedef short bf16x8 __attribute__((ext_vector_type(8)));
typedef short s16x4 __attribute__((ext_vector_type(4)));
typedef float f32x16 __attribute__((ext_vector_type(16)));
typedef float f32x4 __attribute__((ext_vector_type(4)));
typedef unsigned u32x4 __attribute__((ext_vector_type(4)));
#define ATT_LAS __attribute__((address_space(3)))

#define KSWZ(row, colB) ((row) * 256 + ((colB) ^ (((row) & 7) << 4)))
#define SBAR() __builtin_amdgcn_sched_barrier(0)
__device__ __forceinline__ int v_st(int k, int c) { const int kk = (k & ~0xC) | ((k & 4) << 1) | ((k & 8) >> 1); return ((kk >> 3) * 4 + (c >> 5)) * 512 + ((kk & 7) * 32 + (c & 31)) * 2; }
__device__ __forceinline__ int v_rd_base(int lane) { return ((lane & 3) << 3) | (((lane >> 2) & 3) << 6) | (((lane >> 4) & 1) << 5) | (((lane >> 5) & 1) << 8); }
constexpr int v_rd_off(int d0, int ks, int half) { return d0 * 512 + ks * 4096 + half * 2048; }
__device__ __forceinline__ int crow(int r, int hi) { return (r & 3) + 8 * (r >> 2) + 4 * hi; }
__device__ __forceinline__ unsigned cvtpk(float lo, float hi) { unsigned r; asm volatile("v_cvt_pk_bf16_f32 %0, %1, %2" : "=v"(r) : "v"(lo), "v"(hi)); return r; }
__device__ __forceinline__ bf16x8 load8(const bf16* p) { return *reinterpret_cast<const bf16x8*>(p); }

__device__ __forceinline__ void mask_tile(f32x16& p0, f32x16& p1, int dq, unsigned W) {
    const float NEG = -__builtin_inff();
#pragma unroll
    for (int r = 0; r < 16; ++r) {
        const int c = (r & 3) + 8 * (r >> 2);
        if ((unsigned)(dq - c) >= W) p0[r] = NEG;
        if ((unsigned)(dq - c - 32) >= W) p1[r] = NEG;
    }
}
__device__ __forceinline__ void mask_bits(f32x16& p0, f32x16& p1, unsigned long long w, int hi) {
    const float NEG = -__builtin_inff();
    const unsigned lo = (unsigned)w >> (4 * hi), hh = (unsigned)(w >> 32) >> (4 * hi);
#pragma unroll
    for (int r = 0; r < 16; ++r) {
        const int c = (r & 3) + 8 * (r >> 2);
        if (!((lo >> c) & 1u)) p0[r] = NEG;
        if (!((hh >> c) & 1u)) p1[r] = NEG;
    }
}
__device__ __forceinline__ void partialSM(f32x16& p0, f32x16& p1, float& m_reg, float& mn, float& alpha) {
    float pmax = p0[0]; for (int r = 1; r < 16; ++r) pmax = fmaxf(pmax, p0[r]); for (int r = 0; r < 16; ++r) pmax = fmaxf(pmax, p1[r]);
    { auto rr = __builtin_amdgcn_permlane32_swap(__float_as_uint(pmax), __float_as_uint(pmax), false, false);
      pmax = fmaxf(__uint_as_float(rr[0]), __uint_as_float(rr[1])); }
    constexpr float C2 = 1.4426950408889634f * SCALE;
    if (__builtin_expect(__all((pmax - m_reg) * SCALE <= THR), 1)) { mn = m_reg; alpha = 1.f; }
    else { mn = fmaxf(m_reg, pmax); alpha = __builtin_amdgcn_exp2f((m_reg - mn) * C2); m_reg = mn; }
    const float mnL = -mn * C2;
    for (int r = 0; r < 16; ++r) p0[r] = fmaf(p0[r], C2, mnL); for (int r = 0; r < 16; ++r) p1[r] = fmaf(p1[r], C2, mnL);
    for (int r = 0; r < 16; ++r) p0[r] = __builtin_amdgcn_exp2f(p0[r]);
}
__device__ __forceinline__ void finishSM(f32x16& p0, f32x16& p1, float alpha, float& l_reg, bf16x8& pa0, bf16x8& pa1, bf16x8& pa2, bf16x8& pa3) {
    for (int r = 0; r < 16; ++r) p1[r] = __builtin_amdgcn_exp2f(p1[r]);
    float ps = 0; for (int r = 0; r < 16; ++r) ps += p0[r]; for (int r = 0; r < 16; ++r) ps += p1[r];
    { auto rr = __builtin_amdgcn_permlane32_swap(__float_as_uint(ps), __float_as_uint(ps), false, false);
      ps = __uint_as_float(rr[0]) + __uint_as_float(rr[1]); }
    l_reg = l_reg * alpha + ps;
#define PK4(P, B_, OUT) do { unsigned a0 = cvtpk(P[B_+0], P[B_+1]), a1 = cvtpk(P[B_+2], P[B_+3]);                          \
        unsigned b0 = cvtpk(P[B_+4], P[B_+5]), b1 = cvtpk(P[B_+6], P[B_+7]);                                             \
        auto r0 = __builtin_amdgcn_permlane32_swap(a0, b0, false, false); auto r1 = __builtin_amdgcn_permlane32_swap(a1, b1, false, false); \
        u32x4 w = {r0[0], r1[0], r0[1], r1[1]}; OUT = *reinterpret_cast<bf16x8*>(&w); } while (0)
    PK4(p0, 0, pa0); PK4(p0, 8, pa1); PK4(p1, 0, pa2); PK4(p1, 8, pa3);
#undef PK4
}
template <int KB, int MODE>
__device__ __forceinline__ void qkt(f32x16& p0, f32x16& p1, const char* K_lds, int r32, int hi, const bf16x8* qr, const ATT_LAS float* bias_tile) {
    if constexpr (MODE == 1) {
        const ATT_LAS float* bp = bias_tile + 4 * hi;
#pragma unroll
        for (int g = 0; g < 4; ++g) { const f32x4 a = *(const ATT_LAS f32x4*)(bp + 8 * g), b = *(const ATT_LAS f32x4*)(bp + 32 + 8 * g);
            p0[4 * g] = a[0]; p0[4 * g + 1] = a[1]; p0[4 * g + 2] = a[2]; p0[4 * g + 3] = a[3];
            p1[4 * g] = b[0]; p1[4 * g + 1] = b[1]; p1[4 * g + 2] = b[2]; p1[4 * g + 3] = b[3]; }
    } else { p0 = f32x16{}; p1 = f32x16{}; }
    const char* kb[4];
#pragma unroll
    for (int dd = 0; dd < 4; ++dd) kb[dd] = K_lds + KB * SHM_K + KSWZ(r32, (dd * 16 + hi * 8) * 2);
#pragma unroll
    for (int d0 = 0; d0 < 8; ++d0) { const char* a = kb[d0 & 3] + (d0 >> 2) * 128;
        bf16x8 b0 = *reinterpret_cast<const bf16x8*>(a);
        bf16x8 b1 = *reinterpret_cast<const bf16x8*>(a + 32 * 256);
        p0 = __builtin_amdgcn_mfma_f32_32x32x16_bf16(b0, qr[d0], p0, 0, 0, 0);
        p1 = __builtin_amdgcn_mfma_f32_32x32x16_bf16(b1, qr[d0], p1, 0, 0, 0); }
}
template <int VB>
__device__ __forceinline__ void pv_tile(f32x16* o, int vb0, bf16x8 pa0, bf16x8 pa1, bf16x8 pa2, bf16x8 pa3) {
#define TRRD(dst, off) asm volatile("ds_read_b64_tr_b16 %0, %1 offset:%2" : "=&v"(dst) : "v"(vb0), "i"(off) : "memory")
#define PV_D0(d0) do { s16x4 l0, l1, l2, l3, h0, h1, h2, h3; constexpr int b_ = VB * SHM_V + v_rd_off(d0, 0, 0); \
        TRRD(l0, b_); TRRD(h0, b_ + 2048); TRRD(l1, b_ + 4096); TRRD(h1, b_ + 6144); TRRD(l2, b_ + 8192); TRRD(h2, b_ + 10240); TRRD(l3, b_ + 12288); TRRD(h3, b_ + 14336); \
        asm volatile("s_waitcnt lgkmcnt(0)" ::: "memory"); SBAR();   \
        o[d0] = __builtin_amdgcn_mfma_f32_32x32x16_bf16(pa0, (bf16x8){l0[0], l0[1], l0[2], l0[3], h0[0], h0[1], h0[2], h0[3]}, o[d0], 0, 0, 0);   \
        o[d0] = __builtin_amdgcn_mfma_f32_32x32x16_bf16(pa1, (bf16x8){l1[0], l1[1], l1[2], l1[3], h1[0], h1[1], h1[2], h1[3]}, o[d0], 0, 0, 0);   \
        o[d0] = __builtin_amdgcn_mfma_f32_32x32x16_bf16(pa2, (bf16x8){l2[0], l2[1], l2[2], l2[3], h2[0], h2[1], h2[2], h2[3]}, o[d0], 0, 0, 0);   \
        o[d0] = __builtin_amdgcn_mfma_f32_32x32x16_bf16(pa3, (bf16x8){l3[0], l3[1], l3[2], l3[3], h3[0], h3[1], h3[2], h3[3]}, o[d0], 0, 0, 0); } while (0)
    PV_D0(0); PV_D0(1); PV_D0(2); PV_D0(3);
#undef PV_D0
#undef TRRD
}

struct BlockRef { const bf16* Q; const bf16* K; const bf16* V; bf16* O; int P0; const unsigned long long* mrow; };
struct Seam { bf16x8 qr[8]; bf16x8 st_v0, st_v1, st_k0, st_k1; };
__device__ __forceinline__ int swa_jlo(int P0, int W) { const int lowk = P0 - W + 1; return lowk > 0 ? lowk / KVBLK : 0; }
#define ROW(p, k0, rr) ((p) + (size_t)((k0) + (rr)) * D + sc)
#define VMW() asm volatile("s_waitcnt vmcnt(0)" ::: "memory")
#define VMWN(n) asm volatile("s_waitcnt vmcnt(%0)" :: "i"(n) : "memory")
#define SLOAD_H(Kp, Vp, k0) do { S.st_v0 = load8(ROW(Vp, k0, sr)); S.st_v1 = load8(ROW(Vp, k0, 32 + sr));              \
                         S.st_k0 = load8(ROW(Kp, k0, sr)); S.st_k1 = load8(ROW(Kp, k0, 32 + sr)); } while (0)
#define SWRITE_HK(bf) do { *(bf16x8*)(K_lds + (bf) * SHM_K + kws) = S.st_k0; *(bf16x8*)(K_lds + (bf) * SHM_K + kws + 32 * 256) = S.st_k1; } while (0)
#define SWRITE_HV(bf) do { *(bf16x8*)(V_lds + (bf) * SHM_V + vst0) = S.st_v0; *(bf16x8*)(V_lds + (bf) * SHM_V + vst1) = S.st_v1; } while (0)
#define SWRITE_H(bf) do { SWRITE_HV(bf); SWRITE_HK(bf); } while (0)
__device__ __forceinline__ void attn_prime(const BlockRef& cur, int W, char* lds, Seam& S) {
    const int tid = threadIdx.x, wid = __builtin_amdgcn_readfirstlane(tid >> 6), lane = tid & 63, r32 = lane & 31, hi = lane >> 5;
    const int sr = tid >> 4, sc = (tid & 15) * 8, kws = KSWZ(sr, sc * 2); char* K_lds = lds + 2 * SHM_V;
    const int kb0 = swa_jlo(cur.P0, W) * KVBLK;
    for (int d0 = 0; d0 < 8; ++d0) S.qr[d0] = load8(cur.Q + (size_t)(wid * QBLK + r32) * D + d0 * 16 + hi * 8);
    SLOAD_H(cur.K, cur.V, kb0); VMW(); SWRITE_HK(0);
    __syncthreads();
}
template <int MODE>
__device__ __forceinline__ void attn_block(const BlockRef& cur, const BlockRef& nxt, int skv, int W, int ldo, char* lds, Seam& S) {
    const int tid = threadIdx.x, wid = __builtin_amdgcn_readfirstlane(tid >> 6), lane = tid & 63, r32 = lane & 31, hi = lane >> 5;
    const int j_lo = swa_jlo(cur.P0, W);
    int j_hi = (cur.P0 + QB - 1) / KVBLK + 1; if (j_hi > skv / KVBLK) j_hi = skv / KVBLK;
    const int NT = j_hi - j_lo;
    const int kbn = swa_jlo(nxt.P0, W) * KVBLK;
    const int qlo = cur.P0 + wid * QBLK, qm = qlo + r32 - 4 * hi;
    char* V_lds = lds; char* K_lds = lds + 2 * SHM_V;
    float* ws = (float*)(lds + LDS_WS) + wid * 64; float* li_l = ws, * al_l = ws + 32;
    const ATT_LAS float* bias_l = (const ATT_LAS float*)(ATT_LAS char*)(lds + LDS_BIAS);
    float m_reg = -1e30f, l_reg = 0; f32x16 o[4] = {};
    const int sr = tid >> 4, sc = (tid & 15) * 8, vst0 = v_st(sr, sc), vst1 = v_st(32 + sr, sc), kws = KSWZ(sr, sc * 2);
    const int vb0 = (int)(uintptr_t)V_lds + v_rd_base(lane);
    const bf16* Kh = cur.K; const bf16* Vh = cur.V;
    const unsigned long long* mw = (MODE == 2) ? cur.mrow + (size_t)(wid * QBLK + r32) * 64 + j_lo : nullptr;
    unsigned long long mwA = 0, mwB = 0;
#define RESC(a) do { if (__any((a) < 1.f)) { if (hi == 0) al_l[r32] = (a); asm volatile("s_waitcnt lgkmcnt(0)" ::: "memory");              \
                     for (int d_ = 0; d_ < 4; ++d_) for (int r = 0; r < 16; ++r) o[d_][r] *= al_l[crow(r, hi)]; } } while (0)
#define KBASE(t) ((j_lo + (t)) * KVBLK)
#define BIAS_T(t) (bias_l + KBASE(t))
#define MASKT(P0_, P1_, MW_, t) do { if constexpr (MODE == 2) { mask_bits(P0_, P1_, MW_, hi); } else if constexpr (MODE != 3) { const int kb_ = KBASE(t); \
        if (kb_ + KVBLK - 1 > qlo || kb_ <= qlo + QBLK - 1 - W) mask_tile(P0_, P1_, qm - kb_, (unsigned)W); } } while (0)
#define LOADW(MW_, t) do { if constexpr (MODE == 2) { MW_ = mw[(t)]; } } while (0)
    constexpr int NQL = 8;
#define SEAM_K0() do { VMWN(NQL); SWRITE_HK(0); SBAR(); } while (0)
    f32x16 pA0, pA1, pB0, pB1; float mnA, mnB, alA, alB; bf16x8 pa0, pa1, pa2, pa3;
    SWRITE_HV(0); SBAR();
    LOADW(mwA, 0);
    if (NT > 1) { SLOAD_H(Kh, Vh, KBASE(1)); }
    SBAR(); qkt<0, MODE>(pA0, pA1, K_lds, r32, hi, S.qr, BIAS_T(0));
    MASKT(pA0, pA1, mwA, 0); partialSM(pA0, pA1, m_reg, mnA, alA);
    if (NT > 1) { VMW(); SWRITE_H(1); }
    __syncthreads();
#define HALF_STEP(PX0, PX1, mnX, alX, MWX, PY0, PY1, alY, t, KB, VB, SB) do {                                               \
        SBAR(); LOADW(MWX, t); qkt<KB, MODE>(PX0, PX1, K_lds, r32, hi, S.qr, BIAS_T(t));                                      \
        finishSM(PY0, PY1, alY, l_reg, pa0, pa1, pa2, pa3); SBAR();                                                           \
        if ((t) + 1 < NT) { SLOAD_H(Kh, Vh, KBASE((t) + 1)); SBAR(); }                                                        \
        pv_tile<VB>(o, vb0, pa0, pa1, pa2, pa3); MASKT(PX0, PX1, MWX, (t)); partialSM(PX0, PX1, m_reg, mnX, alX);             \
        __syncthreads();                                                                                                      \
        if ((t) + 1 < NT) { VMW(); SWRITE_H(SB); }                                                                            \
        RESC(alX); __syncthreads(); } while (0)
    for (int t = 1; t + 1 < NT; t += 2) {
        HALF_STEP(pB0, pB1, mnB, alB, mwB, pA0, pA1, alA, t, 1, 0, 0);
        HALF_STEP(pA0, pA1, mnA, alA, mwA, pB0, pB1, alB, t + 1, 0, 1, 1);
    }
    const bool even = (NT & 1) == 0;
    if (even) { SBAR(); LOADW(mwB, NT - 1); qkt<1, MODE>(pB0, pB1, K_lds, r32, hi, S.qr, BIAS_T(NT - 1)); SBAR(); }
    SLOAD_H(nxt.K, nxt.V, kbn); SBAR();
#pragma unroll
    for (int d0 = 0; d0 < 8; ++d0) S.qr[d0] = load8(nxt.Q + (size_t)(wid * QBLK + r32) * D + d0 * 16 + hi * 8);
    SBAR();
    finishSM(pA0, pA1, alA, l_reg, pa0, pa1, pa2, pa3); SBAR();
    pv_tile<0>(o, vb0, pa0, pa1, pa2, pa3);
    if (even) { MASKT(pB0, pB1, mwB, NT - 1); partialSM(pB0, pB1, m_reg, mnB, alB); __syncthreads(); RESC(alB);
        finishSM(pB0, pB1, alB, l_reg, pa0, pa1, pa2, pa3); SBAR(); pv_tile<1>(o, vb0, pa0, pa1, pa2, pa3); }
    SBAR(); SEAM_K0();
    if (hi == 0) li_l[r32] = l_reg; asm volatile("s_waitcnt lgkmcnt(0)" ::: "memory");
    float rli[16];
#pragma unroll
    for (int r = 0; r < 16; ++r) rli[r] = __builtin_amdgcn_rcpf(li_l[crow(r, hi)]);
    bf16* Ow = cur.O + (size_t)(wid * QBLK) * ldo;
    ATT_LAS char* stg = (ATT_LAS char*)(lds + LDS_STG + wid * 4352);
#pragma unroll
    for (int ph = 0; ph < 2; ++ph) {
#pragma unroll
        for (int rr = 0; rr < 8; ++rr) { const int r = 8 * ph + rr, srow = crow(r, hi) - 16 * ph;
#pragma unroll
            for (int d0 = 0; d0 < 4; ++d0) *(ATT_LAS unsigned short*)(stg + srow * 272 + (d0 * 32 + r32) * 2) = (unsigned short)cvtpk(o[d0][r] * rli[r], 0.f); }
#pragma unroll
        for (int i = 0; i < 4; ++i) { const int row = 4 * i + (lane >> 4), c = lane & 15;
            const v4u_t x = *(const ATT_LAS v4u_t*)(stg + row * 272 + c * 16);
            *(v4u_t*)(Ow + (size_t)(16 * ph + row) * ldo + c * 8) = x; } }
    __syncthreads();
#undef RESC
#undef KBASE
#undef BIAS_T
#undef MASKT
#undef LOADW
#undef SEAM_K0
#undef HALF_STEP
}
#undef ROW
#undef VMW
#undef VMWN
#undef SLOAD_H
#undef SWRITE_HK
#undef SWRITE_HV
#undef SWRITE_H
}
struct Args {
    const float* x; const float* mem; const int* positions; const float* attn_norm_g; const float* mem_norm_g; const float* w_in; const float* fox_forget_b;
    const float* fox_q_norm_g; const float* fox_k_norm_g; const float* dsa_q_norm_g; const float* dsa_k_norm_g; const float* idx_k_norm_g;
    const float* cross_q_norm_g; const float* cross_k_norm_g; const float* w_mem_kv; const float* w_branch_fox; const float* w_branch_dsa;
    const float* w_branch_cross; const float* w_out; const float* ffn_norm_g; const float* router_group_w; const float* router_group_b;
    const float* router_expert_w; const float* router_expert_b; const float* expert_w_gate; const float* expert_w_up; const float* expert_w_down;
    float* out; unsigned char* ws; int ph_lo, ph_hi, flags, pad;
};
static_assert(sizeof(Args) == 29 * 8 + 16, "Args has no padding");

struct Frame { int tid, lane, wave, G, c, vcu; };

#define XB_TMO      128
#define XB_XCNT(j)  (256  + 64 * (j))
#define XB_XSUB(j)  (1280 + 64 * (j))
#define XB_XGEN(j)  (2304 + 64 * (j))
#define XB_TOP      3328
#define XB_TOPGEN   3392
#define XCD_BAR_WORDS 3456
#define XB_SPIN_CAP (1u << 22)
__device__ __forceinline__ unsigned xb_ld(unsigned* p)              { return __hip_atomic_load(p, __ATOMIC_RELAXED, __HIP_MEMORY_SCOPE_AGENT); }
__device__ __forceinline__ unsigned xb_add(unsigned* p, unsigned v) { return __hip_atomic_fetch_add(p, v, __ATOMIC_RELAXED, __HIP_MEMORY_SCOPE_AGENT); }
__device__ __forceinline__ unsigned xb_xcc_id() { return (unsigned)__builtin_amdgcn_s_getreg((3 << 11) | 20) & 0xFu; }
#define XB_SPIN(cond, bar) do { unsigned _sp = 0; while (cond) { __builtin_amdgcn_s_sleep(1); \
    if ((++_sp & 255u) == 0u) { if (xb_ld(&(bar)[XB_TMO])) break; if (_sp > XB_SPIN_CAP) { atomicAdd(&(bar)[XB_TMO], 1u); break; } } } } while (0)
struct XcdBarrier { unsigned* bar; unsigned x; volatile LAS unsigned* st; };
__device__ __forceinline__ XcdBarrier xcd_barrier_post(unsigned* bar, volatile LAS unsigned* st) {
    XcdBarrier b; b.bar = bar; b.x = xb_xcc_id(); b.st = st;
    if (threadIdx.x == 0) (void)xb_add(&bar[XB_XCNT(b.x)], 1u);
    return b;
}
__device__ __forceinline__ void xcd_barrier_complete(unsigned* bar, unsigned x, unsigned& nloc, unsigned& nx) {
    const unsigned G = gridDim.x * gridDim.y * gridDim.z;
    unsigned sum, cnt, mine, sp = 0u;
    for (;;) {
        sum = 0u; cnt = 0u; mine = 0u;
#pragma unroll
        for (unsigned j = 0; j < 16; ++j) { const unsigned c = xb_ld(&bar[XB_XCNT(j)]); sum += c; cnt += (c > 0u) ? 1u : 0u; mine = (j == x) ? c : mine; }
        if (sum == G) break;
        __builtin_amdgcn_s_sleep(1);
        if ((++sp & 255u) == 0u) { if (xb_ld(&bar[XB_TMO])) break; if (sp > XB_SPIN_CAP) { atomicAdd(&bar[XB_TMO], 1u); break; } }
    }
    nloc = mine > 0u ? mine : 1u; nx = cnt > 0u ? cnt : 1u;
}
__device__ __forceinline__ void xcd_barrier(const XcdBarrier& b) {
    asm volatile("s_waitcnt vmcnt(0)" ::: "memory");
    __syncthreads();
    if (threadIdx.x == 0) {
        unsigned* bar = b.bar;
        __builtin_amdgcn_s_waitcnt(0);
        unsigned nloc = b.st[0], nx = b.st[1];
        if (nloc == 0u) { xcd_barrier_complete(bar, b.x, nloc, nx); b.st[0] = nloc; b.st[1] = nx; }
        const unsigned old = xb_add(&bar[XB_XSUB(b.x)], 1u);
        const unsigned gen = old / nloc;
        if (old + 1u == (gen + 1u) * nloc) {
            __builtin_amdgcn_fence(__ATOMIC_RELEASE, "agent");
            asm volatile("s_waitcnt vmcnt(0)" ::: "memory");
            const unsigned og = xb_add(&bar[XB_TOP], 1u);
            const unsigned tg = og / nx;
            if (og + 1u == (tg + 1u) * nx) xb_add(&bar[XB_TOPGEN], 1u);
            else XB_SPIN(xb_ld(&bar[XB_TOPGEN]) == tg, bar);
            __builtin_amdgcn_fence(__ATOMIC_ACQUIRE, "agent");
            xb_add(&bar[XB_XGEN(b.x)], 1u);
            asm volatile("s_waitcnt vmcnt(0)" ::: "memory");
        } else {
            XB_SPIN(xb_ld(&bar[XB_XGEN(b.x)]) == gen, bar);
            __builtin_amdgcn_fence(__ATOMIC_ACQUIRE, "agent");
            asm volatile("s_waitcnt vmcnt(0)" ::: "memory");
        }
    }
    __syncthreads();
}


struct TItem { const float* colp; bf16* WT; int srcN, k0, drow0, K; };
__device__ __forceinline__ void titem_load(const TItem& t, float (&v)[32], int lane) {
#pragma unroll
    for (int i = 0; i < 32; ++i) { const int kk = 2 * i + (lane >> 5); v[i] = t.colp ? t.colp[(size_t)(t.k0 + kk) * t.srcN] : 0.f; }
}
__device__ __forceinline__ void titem_store(const TItem& t, const float (&v)[32], LAS float* scr, int lane) {
    const int n = lane & 31;
#pragma unroll
    for (int i = 0; i < 32; ++i) { const int kk = 2 * i + (lane >> 5); scr[kk * 33 + n] = v[i]; }
    LDS_WAIT(); asm volatile("" ::: "memory");
    const int c = lane & 7;
#pragma unroll
    for (int j = 0; j < 4; ++j) { const int nn = (lane >> 3) + 8 * j; const LAS float* s = scr + (8 * c) * 33 + nn;
        v4u o; o.x = pk2(s[0 * 33], s[1 * 33]); o.y = pk2(s[2 * 33], s[3 * 33]); o.z = pk2(s[4 * 33], s[5 * 33]); o.w = pk2(s[6 * 33], s[7 * 33]);
        *(GAS v4u*)(t.WT + (size_t)(t.drow0 + nn) * t.K + t.k0 + 8 * c) = o; }
    LDS_WAIT(); asm volatile("" ::: "memory");
}
__device__ __forceinline__ void rms_row_to_bf16(const float* xrow, const float* g, bf16* orow, int lane) {
    const GAS f32x4* xr = (const GAS f32x4*)xrow + lane; const GAS f32x4* gr = (const GAS f32x4*)g + lane;
    f32x4 v[8]; float s = 0.f;
#pragma unroll
    for (int j = 0; j < 8; ++j) { v[j] = xr[64 * j]; s += (v[j].x * v[j].x + v[j].y * v[j].y) + (v[j].z * v[j].z + v[j].w * v[j].w); }
    const float rs = 1.0f / sqrtf(wave_sum(s) * (1.f / DM) + EPS);
    GAS v2u* o8 = (GAS v2u*)orow + lane;
#pragma unroll
    for (int j = 0; j < 8; ++j) { const f32x4 gg = gr[64 * j]; v2u w; w.x = pk2(v[j].x * rs * gg.x, v[j].y * rs * gg.y); w.y = pk2(v[j].z * rs * gg.z, v[j].w * rs * gg.w); o8[64 * j] = w; }
}
constexpr int P0_T1 = 32 * (N1 / 32) + 32 * 32, P0_T5 = P0_T1 + 12 * 64 + 12 * 64 + 8 * 64 + 32 * 64;
__device__ __forceinline__ void p0_items(const Args& A, const Frame& F, LAS unsigned char* lds, int start, int stride, int lo, int hi) {
    LAS float* scr = (LAS float*)(lds + F.wave * 16384);
    const int lane = F.lane, n = lane & 31;
    unsigned char* ws = A.ws;
    constexpr int I_IN = 32 * (N1 / 32), I_MKV = 32 * 32, I_BF = 12 * 64, I_BC = 8 * 64, I_OUT = 32 * 64, I_GU = 32 * 64, I_D = 16 * 64;
    constexpr int T0 = I_IN, T1 = T0 + I_MKV, T2 = T1 + I_BF, T3 = T2 + I_BF, T4 = T3 + I_BC, T5 = T4 + I_OUT, T6 = T5, T7 = T6;
    auto decode = [&](int it) -> TItem { TItem t;
        if (it < T0) { const int nb = it % (N1 / 32), kb = it / (N1 / 32); const int sc = win_src_col(nb * 32 + n);
            t.colp = sc >= 0 ? A.w_in + sc : nullptr; t.srcN = INW; t.k0 = kb * 64; t.WT = (bf16*)(ws + WS_WIN); t.drow0 = nb * 32; t.K = DM; }
        else if (it < T1) { const int r = it - T0, nb = r % 32, kb = r / 32; t.colp = A.w_mem_kv + nb * 32 + n; t.srcN = 1024; t.k0 = kb * 64; t.WT = (bf16*)(ws + WS_WMKV); t.drow0 = nb * 32; t.K = DM; }
        else if (it < T2) { const int r = it - T1, nb = r % 64, kb = r / 64; t.colp = A.w_branch_fox + nb * 32 + n; t.srcN = DM; t.k0 = kb * 64; t.WT = (bf16*)(ws + WS_WBF); t.drow0 = nb * 32; t.K = DM; }
        else if (it < T3) { const int r = it - T2, nb = r % 64, kb = r / 64; t.colp = A.w_branch_dsa + nb * 32 + n - (size_t)FOXW * DM; t.srcN = DM; t.k0 = FOXW + kb * 64; t.WT = (bf16*)(ws + WS_WBF); t.drow0 = nb * 32; t.K = DM; }
        else if (it < T4) { const int r = it - T3, nb = r % 64, kb = r / 64; t.colp = A.w_branch_cross + nb * 32 + n - (size_t)(FOXW + DSAW) * DM; t.srcN = DM; t.k0 = FOXW + DSAW + kb * 64; t.WT = (bf16*)(ws + WS_WBF); t.drow0 = nb * 32; t.K = DM; }
        else if (it < T5) { const int r = it - T4, nb = r % 64, kb = r / 64; t.colp = A.w_out + nb * 32 + n; t.srcN = DM; t.k0 = kb * 64; t.WT = (bf16*)(ws + WS_WOUT); t.drow0 = nb * 32; t.K = DM; }
        else if (it < T6) { const int r = it - T5, e = r / I_GU, q = r % I_GU, nb = q % 64, kb = q / 64;
            t.colp = (n < 16 ? A.expert_w_gate : A.expert_w_up) + (size_t)e * DM * FF + 16 * nb + (n & 15); t.srcN = FF; t.k0 = kb * 64; t.WT = (bf16*)(ws + WS_WGU) + (size_t)e * 2048 * DM; t.drow0 = nb * 32; t.K = DM; }
        else { const int r = it - T6, e = r / I_D, q = r % I_D, nb = q % 64, kb = q / 64;
            t.colp = A.expert_w_down + (size_t)e * FF * DM + nb * 32 + n; t.srcN = DM; t.k0 = kb * 64; t.WT = (bf16*)(ws + WS_WD) + (size_t)e * DM * FF; t.drow0 = nb * 32; t.K = FF; }
        return t; };
    static_assert(T1 == P0_T1 && T5 == P0_T5 && T7 == T5, "item ranges");
    if (lo + start < hi) {
        float va[32], vb[32]; int it = lo + start; TItem ta = decode(it), tb; titem_load(ta, va, lane);
        for (;;) {
            int itn = it + stride; bool hn = itn < hi;
            if (hn) { tb = decode(itn); titem_load(tb, vb, lane); }
            titem_store(ta, va, scr, lane);
            if (!hn) break;
            it = itn; itn = it + stride; hn = itn < hi;
            if (hn) { ta = decode(itn); titem_load(ta, va, lane); }
            titem_store(tb, vb, scr, lane);
            if (!hn) break;
            it = itn;
        }
    }
}
__device__ __forceinline__ void p0_prologue(const Args& A, const Frame& F, LAS unsigned char* lds) {
    const int gw = F.vcu * NWAVES + F.wave, NGW = F.G * NWAVES, lane = F.lane;
    unsigned char* ws = A.ws;
    p0_items(A, F, lds, gw, NGW, 0, P0_T1);
    for (int m = NGW - 1 - gw; m < MTOK + 512; m += NGW) {
        if (m < MTOK) rms_row_to_bf16(A.x + (size_t)m * DM, A.attn_norm_g, (bf16*)(ws + WS_H) + (size_t)m * DM, lane);
        else rms_row_to_bf16(A.mem + (size_t)(m - MTOK) * DM, A.mem_norm_g, (bf16*)(ws + WS_MEMN) + (size_t)(m - MTOK) * DM, lane);
    }
}

struct Sched1 {
    int G, c; const char* H; const char* WIN; const char* WMKV; unsigned memoff;
    static constexpr int NU1 = 32 * 47, NU = NU1 + 8;
    bool tail;
    __device__ __forceinline__ bool next(int i, pg8::Unit& u) const {
        if (tail) { if (i > 0 || c >= 64) return false; u.pm = c & 31; u.pn = 47 + (c >> 5); u.e = 0; u.aux = 0; return true; }
        const int L = i * G + c; if (L >= NU) return false;
        if (L < NU1) { pg8::tile_order(L, 32, 47, u.pm, u.pn); u.e = 0; } else { const int r = L - NU1; u.pm = r >> 2; u.pn = r & 3; u.e = 1; }
        u.aux = 0; return true;
    }
    __device__ __forceinline__ const char* abase() const { return H; }
    __device__ __forceinline__ unsigned arow_off(const pg8::Unit& u, int r) const { return (u.e ? memoff : 0u) + (unsigned)(u.pm * 256 + r) * (unsigned)(DM * 2); }
    __device__ __forceinline__ const char* bbase(const pg8::Unit& u) const { return (u.e ? WMKV : WIN) + (size_t)u.pn * 256 * DM * 2; }
};
struct Epi1 {
    static constexpr bool PERM = true;
    bf16* PROJ; bf16* MKV; bf16* VF; bf16* VD; LAS unsigned char* stg;
    __device__ __forceinline__ void operator()(const pg8::f32x4 (&acc)[2][2][4][2], const pg8::Unit& u, int wr, int wc, int fr, int fq) const {
        bf16* base = u.e ? MKV : PROJ; const int ldc = u.e ? 1024 : N1;
        const int vt = u.e ? -1 : ((u.pn >= 6 && u.pn < 9) ? u.pn - 6 : ((u.pn >= 15 && u.pn < 18) ? u.pn - 15 + 3 : -1));
        const int L = fr + 16 * fq, w8 = wr * 4 + wc, c = L & 31;
        LAS unsigned char* wp = stg + (wr * 16 + fr) * 528 + (wc * 32 + 8 * fq) * 2;
#pragma unroll
        for (int ai = 0; ai < 2; ++ai)
#pragma unroll
            for (int m = 0; m < 4; ++m) {
#pragma unroll
                for (int bj = 0; bj < 2; ++bj) { pg8::f32x4 v0 = acc[ai][bj][m][0], v1 = acc[ai][bj][m][1];
                    if (!u.e && (u.pn > 24 || (u.pn == 24 && bj == 1))) {
#pragma unroll
                        for (int j = 0; j < 4; ++j) { v0[j] = 1.0f + __expf(-fminf(fmaxf(v0[j], -30.f), 30.f)); v1[j] = 1.0f + __expf(-fminf(fmaxf(v1[j], -30.f), 30.f)); } }
                    pg8::u32x4 w; w.x = pg8::cvt_pk_bf16(v0[0], v0[1]); w.y = pg8::cvt_pk_bf16(v0[2], v0[3]); w.z = pg8::cvt_pk_bf16(v1[0], v1[1]); w.w = pg8::cvt_pk_bf16(v1[2], v1[3]);
                    *(LAS pg8::u32x4*)(wp + bj * 256) = w; }
                asm volatile("s_waitcnt lgkmcnt(0)" ::: "memory"); __builtin_amdgcn_s_barrier();
#pragma unroll
                for (int i = 0; i < 2; ++i) { const int R = 4 * w8 + 2 * i + (L >> 5);
                    const pg8::u32x4 x = *(const LAS pg8::u32x4*)(stg + R * 528 + c * 16);
                    const int grow = u.pm * 256 + ai * 128 + (R >> 4) * 64 + m * 16 + (R & 15);
                    if (vt >= 0) { bf16* V = vt < 3 ? VF : VD; const int b = grow / SEQ, sq = grow % SEQ, hh = (vt % 3) * 2 + (c >> 4);
                        *(pg8::u32x4*)(V + ((size_t)(b * 6 + hh) * SEQ + sq) * HD + (c & 15) * 8) = x; }
                    else *(pg8::u32x4*)(base + (size_t)grow * ldc + u.pn * 256 + c * 8) = x; }
                asm volatile("s_waitcnt lgkmcnt(0)" ::: "memory"); __builtin_amdgcn_s_barrier(); }
    }
};

__device__ __forceinline__ float log_sigmoid(float z) { return fminf(z, 0.f) - log1pf(expf(-fabsf(z))); }
__device__ __forceinline__ void head_rms(const bf16* p, const float* g, int lane, float& a, float& b) {
    const unsigned w = *(const unsigned*)(p + 2 * lane); a = bflo(w); b = bfhi(w);
    const float ss = wave_sum(a * a + b * b); const float rs = 1.0f / sqrtf(ss * (1.f / 128.f) + EPS);
    a = a * rs * g[2 * lane]; b = b * rs * g[2 * lane + 1];
}
__device__ __forceinline__ void head_rms_w(unsigned w, const float2 g2, float& a, float& b) {
    a = bflo(w); b = bfhi(w);
    const float ss = wave_sum(a * a + b * b); const float rs = 1.0f / sqrtf(ss * (1.f / 128.f) + EPS);
    a = a * rs * g2.x; b = b * rs * g2.y;
}
struct RopeFreq { float f32a, f32b, f16a, f16b; };
__device__ __forceinline__ RopeFreq rope_freqs(int lane) {
    RopeFreq r; const int i0 = (2 * lane) & 15, i1 = (2 * lane + 1) & 15, l31 = lane & 31, k0 = (2 * l31) & 7, k1 = (2 * l31 + 1) & 7;
    r.f32a = powf(ROPE_THETA, -(float)i0 * 2.0f / 32.0f); r.f32b = powf(ROPE_THETA, -(float)i1 * 2.0f / 32.0f);
    r.f16a = powf(ROPE_THETA, -(float)k0 * 2.0f / 16.0f); r.f16b = powf(ROPE_THETA, -(float)k1 * 2.0f / 16.0f);
    return r;
}
struct P1bRow { unsigned w[49]; int pos; unsigned short xiw, xfl; };
__device__ __forceinline__ void p1b_load(const Args& A, int row, int lane, P1bRow& R) {
    const bf16* pr = (const bf16*)(A.ws + WS_PROJ) + (size_t)row * N1;
#pragma unroll
    for (int j = 0; j < 49; ++j) if (!((j >= 12 && j < 18) || (j >= 30 && j < 36))) R.w[j] = *(const unsigned*)(pr + 128 * j + 2 * lane);
    R.pos = A.positions[row]; R.xiw = pr[C_IW + (lane & 15)]; R.xfl = pr[C_FL + (lane < 6 ? lane : 0)];
}
__device__ __forceinline__ void p1b_row(const Args& A, int row, int lane, const RopeFreq& RF, const P1bRow& R) {
    unsigned char* ws = A.ws;
    const int b = row / SEQ, s = row % SEQ;
    const unsigned (&w)[49] = R.w;
    const float pos = (float)R.pos;
    const float2 gfq = *(const float2*)(A.fox_q_norm_g + 2 * lane), gfk = *(const float2*)(A.fox_k_norm_g + 2 * lane), gdq = *(const float2*)(A.dsa_q_norm_g + 2 * lane),
                 gdk = *(const float2*)(A.dsa_k_norm_g + 2 * lane), gcq = *(const float2*)(A.cross_q_norm_g + 2 * lane);
    float c32a = 1.f, s32a = 0.f, c32b = 1.f, s32b = 0.f;
    if (lane < 16) { __sincosf(pos * RF.f32a, &s32a, &c32a); __sincosf(pos * RF.f32b, &s32b, &c32b); }
    float c16a = 1.f, s16a = 0.f, c16b = 1.f, s16b = 0.f;
    if ((lane & 31) < 8) { __sincosf(pos * RF.f16a, &s16a, &c16a); __sincosf(pos * RF.f16b, &s16b, &c16b); }
    float rs[29];
#pragma unroll
    for (int i = 0; i < 29; ++i) { const int j = i < 12 ? i : (i < 24 ? i + 6 : (i < 28 ? i + 12 : 48)); const float a = bflo(w[j]), c = bfhi(w[j]); rs[i] = (i == 28 && lane >= 32) ? 0.f : a * a + c * c; }
#pragma unroll
    for (int o = 1; o < 64; o <<= 1) { float t[29];
#pragma unroll
        for (int i = 0; i < 29; ++i) t[i] = __shfl_xor(rs[i], o);
#pragma unroll
        for (int i = 0; i < 29; ++i) rs[i] += t[i]; }
#pragma unroll
    for (int i = 0; i < 29; ++i) rs[i] = __builtin_amdgcn_rsqf(rs[i] * (i == 28 ? 1.f / 64.f : 1.f / 128.f) + EPS);
#define HEAD_N(wv, g2, r_, a_, c_) do { a_ = bflo(wv) * (r_) * (g2).x; c_ = bfhi(wv) * (r_) * (g2).y; } while (0)
#pragma unroll
    for (int h = 0; h < 6; ++h) {
        const size_t ho = ((size_t)(b * 6 + h) * SEQ + s) * HD + 2 * lane;
        float a, c;
        HEAD_N(w[h], gfq, rs[h], a, c); *(unsigned*)((bf16*)(ws + WS_QF) + ho) = pk2(a, c);
        HEAD_N(w[6 + h], gfk, rs[6 + h], a, c); *(unsigned*)((bf16*)(ws + WS_KF) + ho) = pk2(a, c);
#pragma unroll
        for (int qk = 0; qk < 2; ++qk) {
            HEAD_N(w[(qk ? 24 : 18) + h], (qk ? gdk : gdq), rs[(qk ? 18 : 12) + h], a, c);
            const float pa = __shfl_xor(a, 8), pc = __shfl_xor(c, 8);
            if (lane < 8) { a = a * c32a - pa * s32a; c = c * c32b - pc * s32b; }
            else if (lane < 16) { a = a * c32a + pa * s32a; c = c * c32b + pc * s32b; }
            *(unsigned*)((bf16*)(ws + (qk ? WS_KD : WS_QD)) + ho) = pk2(a, c);
        }
    }
#pragma unroll
    for (int h = 0; h < 4; ++h) { float a, c; HEAD_N(w[36 + h], gcq, rs[24 + h], a, c);
        *(unsigned*)((bf16*)(ws + WS_QC) + ((size_t)(b * 4 + h) * SEQ + s) * HD + 2 * lane) = pk2(a, c); }
    const int l31 = lane & 31;
#pragma unroll
    for (int hp = 0; hp < 8; ++hp) {
        float a = bflo(w[40 + hp]), c = bfhi(w[40 + hp]);
        const float pa = __shfl_xor(a, 4), pc = __shfl_xor(c, 4);
        if (l31 < 4) { a = a * c16a - pa * s16a; c = c * c16b - pc * s16b; }
        else if (l31 < 8) { a = a * c16a + pa * s16a; c = c * c16b + pc * s16b; }
        *(unsigned*)((bf16*)(ws + WS_QI) + (size_t)row * (IDXH * IDXD) + hp * 128 + 2 * lane) = pk2(a, c);
    }
    { float a = 0.f, c = 0.f; if (lane < 32) { a = bflo(w[48]); c = bfhi(w[48]); }
      if (lane < 32) { const float2 gk = *(const float2*)(A.idx_k_norm_g + 2 * lane); a = a * rs[28] * gk.x; c = c * rs[28] * gk.y; }
      const float pa = __shfl_xor(a, 4), pc = __shfl_xor(c, 4);
      if (lane < 4) { a = a * c16a - pa * s16a; c = c * c16b - pc * s16b; }
      else if (lane < 8) { a = a * c16a + pa * s16a; c = c * c16b + pc * s16b; }
      if (lane < 32) { const int d = 2 * lane; *(unsigned*)((bf16*)(ws + WS_KI) + ((size_t)(row >> 5) * 8 + (d >> 3)) * 256 + (row & 31) * 8 + (d & 7)) = pk2(a, c); } }
    if (lane < 16) ((float*)(ws + WS_WI))[(size_t)row * IDXH + lane] = bf2f(R.xiw) * 0.25f;
    if (lane < 6) ((float*)(ws + WS_LOGF))[(size_t)(b * 6 + lane) * SEQ + s] = log_sigmoid(bf2f(R.xfl) + A.fox_forget_b[lane]);
#undef HEAD_N
}
__device__ __forceinline__ void p1b_memrow(const Args& A, int mrow, int lane) {
    unsigned char* ws = A.ws; const bf16* pr = (const bf16*)(ws + WS_MKV) + (size_t)mrow * 1024; const int b = mrow / NMEM, m = mrow % NMEM;
#pragma unroll 1
    for (int h = 0; h < 4; ++h) { float a, c; head_rms(pr + h * HD, A.cross_k_norm_g, lane, a, c);
        const size_t ho = ((size_t)(b * 4 + h) * NMEM + m) * HD + 2 * lane;
        *(unsigned*)((bf16*)(ws + WS_KC) + ho) = pk2(a, c);
        *(unsigned*)((bf16*)(ws + WS_VC) + ho) = *(const unsigned*)(pr + 512 + h * HD + 2 * lane); }
}

__device__ __forceinline__ unsigned fkey(float f) { const unsigned u = __builtin_bit_cast(unsigned, f); return (u & 0x80000000u) ? ~u : (u | 0x80000000u); }
__device__ __forceinline__ void indexer_block(const Args& A, const Frame& F, LAS unsigned char* lds, int b, int rb) {
    unsigned char* ws = A.ws; const int lane = F.lane, w = F.wave, r = lane & 31, h = lane >> 5;
    const int t0 = rb * 16, ta = t0 + 2 * w;
    const bf16* QI = (const bf16*)(ws + WS_QI) + (size_t)(b * SEQ) * (IDXH * IDXD);
    const bf16* KI = (const bf16*)(ws + WS_KI) + (size_t)(b * SEQ) * IDXD;
    const float* WI = (const float*)(ws + WS_WI) + (size_t)(b * SEQ) * IDXH;
    float* SC = (float*)(ws + WS_SCORES) + (size_t)(b * SEQ) * SEQ;
    bf16x8 qa[4];
#pragma unroll
    for (int ks = 0; ks < 4; ++ks) qa[ks] = *(const bf16x8*)(QI + (size_t)(ta + (r >> 4)) * (IDXH * IDXD) + (r & 15) * IDXD + ks * 16 + 8 * h);
    float wA[8], wB[8];
#pragma unroll
    for (int q = 0; q < 8; ++q) { const int j = (q & 3) + 8 * (q >> 2) + 4 * h; wA[q] = WI[(size_t)ta * IDXH + j]; wB[q] = WI[(size_t)(ta + 1) * IDXH + j]; }
    const int NT = (A.flags & 2) ? 0 : ((t0 + 16 + 63) >> 6);
    LAS unsigned char* kring = lds + LDSCTL_OFF + 4096;
    const int tid = F.tid;
#define IDX_STAGE(tile_, buf_) __builtin_amdgcn_global_load_lds((const unsigned*)((const char*)KI + (size_t)(tile_) * 8192 + tid * 16), (LAS unsigned*)(kring + (buf_) * 8192 + w * 1024), 16, 0, 0)
    LAS unsigned* rowA = (LAS unsigned*)(lds + w * 16384);
    for (int j = NT >> 2; j < 16; ++j) *(LAS v4u*)(rowA + (j * 64 + lane) * 4) = (v4u){0u, 0u, 0u, 0u};
    __builtin_amdgcn_s_barrier();
    if (NT > 0) IDX_STAGE(0, 0);
    VM_WAIT();
#pragma unroll 1
    for (int tile = 0; tile < NT; ++tile) {
        const int kb = tile * 64;
        asm volatile("s_waitcnt vmcnt(2)" ::: "memory"); __builtin_amdgcn_s_barrier();
        if (tile + 1 < NT) IDX_STAGE(tile + 1, (tile + 1) & 1);
        const LAS unsigned char* kt = kring + (tile & 1) * 8192 + (h * 32 + r) * 16;
        bf16x8 k0[4], k1[4];
#pragma unroll
        for (int ks = 0; ks < 4; ++ks) { k0[ks] = *(const LAS bf16x8*)(kt + ks * 1024); k1[ks] = *(const LAS bf16x8*)(kt + 4096 + ks * 1024); }
        f32x16 p0 = {}, p1 = {};
#pragma unroll
        for (int ks = 0; ks < 4; ++ks) { p0 = __builtin_amdgcn_mfma_f32_32x32x16_bf16(qa[ks], k0[ks], p0, 0, 0, 0); p1 = __builtin_amdgcn_mfma_f32_32x32x16_bf16(qa[ks], k1[ks], p1, 0, 0, 0); }
        float sA0 = 0.f, sB0 = 0.f, sA1 = 0.f, sB1 = 0.f;
#pragma unroll
        for (int q = 0; q < 8; ++q) { sA0 += wA[q] * fmaxf(p0[q], 0.f); sB0 += wB[q] * fmaxf(p0[8 + q], 0.f); sA1 += wA[q] * fmaxf(p1[q], 0.f); sB1 += wB[q] * fmaxf(p1[8 + q], 0.f); }
        sA0 += __shfl_xor(sA0, 32); sB0 += __shfl_xor(sB0, 32); sA1 += __shfl_xor(sA1, 32); sB1 += __shfl_xor(sB1, 32);
        if (h) { float* dst = SC + (size_t)(ta + 1) * SEQ + kb + r; dst[0] = sB0; dst[32] = sB1; }
        else { LAS unsigned* d = rowA + ((tile >> 2) * 64 + r) * 4 + (tile & 3);
            d[0] = kb + r <= ta ? fkey(sA0) : 0u; d[128] = kb + 32 + r <= ta ? fkey(sA1) : 0u; }
    }
#undef IDX_STAGE
    VM_WAIT();
#define WAVE_COUNT(c_) ({ int tot_ = 0; _Pragma("unroll") for (int bb = 0; bb < 7; ++bb) tot_ += __popcll(__ballot(((c_) >> bb) & 1)) << bb; tot_; })
#define CNT_GE(c_, k_, s_) asm("v_cmp_le_u32_e32 vcc, %2, %1\n\tv_addc_co_u32_e32 %0, vcc, 0, %0, vcc" : "+v"(c_) : "v"(k_), "s"(s_) : "vcc")
#define CNT_GT(c_, k_, s_) asm("v_cmp_lt_u32_e32 vcc, %2, %1\n\tv_addc_co_u32_e32 %0, vcc, 0, %0, vcc" : "+v"(c_) : "v"(k_), "s"(s_) : "vcc")
#define WAVE_COUNT3(c_) ({ int tot_ = 0; _Pragma("unroll") for (int bb = 0; bb < 3; ++bb) tot_ += __popcll(__ballot(((c_) >> bb) & 1)) << bb; tot_; })
    LAS unsigned* rowl = (LAS unsigned*)(lds + w * 16384);
    LAS unsigned* lst = (LAS unsigned*)(lds + LDSCTL_OFF + 20480 + w * 1536);
    float fb[64];
    { const float* srowB = SC + (size_t)(ta + 1) * SEQ + lane;
#pragma unroll
      for (int i = 0; i < 64; ++i) fb[i] = srowB[i * 64]; }
#pragma unroll 1
    for (int tl = (A.flags & 1) ? 2 : 0; tl < 2; ++tl) {
        const int t = ta + tl;
        unsigned long long myword = 0ull;
        if (t + 1 <= TOPK) {
            const int nb = t + 1 - lane * 64; myword = nb <= 0 ? 0ull : (nb >= 64 ? ~0ull : ((1ull << nb) - 1ull));
        } else {
            if (tl) {
#pragma unroll
                for (int j = 0; j < 16; ++j) { v4u q;
#pragma unroll
                    for (int e = 0; e < 4; ++e) { const int key = 64 * (4 * j + e) + lane; const unsigned k = fkey(fb[4 * j + e]); q[e] = key <= t ? k : 0u; }
                    *(LAS v4u*)(rowl + (j * 64 + lane) * 4) = q; }
            }
            LDS_WAIT();
            unsigned T = 0u; bool exact = false;
            int mx = -1, G = 0, clo = SEQ, chi = 0; bool tried = false;
#pragma unroll 1
            for (int bit = 31; bit >= 0; --bit) {
                if (!tried && bit < 31 && (bit == 17 || clo - chi <= 80)) {
                    tried = true;
                    const unsigned Thi = T + (2u << bit);
#pragma unroll
                    for (int i = 0; i < 6; ++i) lst[i * 64 + lane] = 0u;
                    int nc = 0;
#pragma unroll 4
                    for (int j = 0; j < 16; ++j) { const v4u q = *(const LAS v4u*)(rowl + (j * 64 + lane) * 4);
#pragma unroll
                        for (int e = 0; e < 4; ++e) { const unsigned k = q[e]; const bool cnd = k >= T && k < Thi;
                            if (cnd && nc < 6) lst[nc * 64 + lane] = k;
                            nc += cnd ? 1 : 0; } }
                    LDS_WAIT();
                    if (__ballot(nc > 6) == 0ull) { G = chi; mx = 0; }
                }
                const unsigned cand = T | (1u << bit); int cnt;
                if (mx >= 0) { int c = 0;
#pragma unroll
                    for (int i = 0; i < 6; ++i) c += (lst[i * 64 + lane] >= cand) ? 1 : 0;
                    cnt = G + WAVE_COUNT3(c);
                } else { int c = 0;
#pragma unroll 8
                    for (int j = 0; j < 16; ++j) { const v4u q = *(const LAS v4u*)(rowl + (j * 64 + lane) * 4);
                        CNT_GE(c, q.x, cand); CNT_GE(c, q.y, cand); CNT_GE(c, q.z, cand); CNT_GE(c, q.w, cand); }
                    cnt = WAVE_COUNT(c); }
                if (cnt >= TOPK) { T = cand; clo = cnt; if (cnt == TOPK) { exact = true; break; } } else chi = cnt;
            }
            if (exact) {
                unsigned mlo = 0u, mhi = 0u;
#pragma unroll
                for (int j = 0; j < 16; ++j) { const v4u q = *(const LAS v4u*)(rowl + (j * 64 + lane) * 4);
#pragma unroll
                    for (int e = 0; e < 4; ++e) { const unsigned long long bal = __ballot(q[e] >= T);
                        asm("s_nop 1\n\tv_writelane_b32 %0, %2, %4\n\tv_writelane_b32 %1, %3, %4" : "+v"(mlo), "+v"(mhi) : "s"((unsigned)bal), "s"((unsigned)(bal >> 32)), "n"(4 * j + e)); } }
                myword = ((unsigned long long)mhi << 32) | mlo;
            } else {
            const unsigned thr = T;
            int g0 = 0;
#pragma unroll 4
            for (int j = 0; j < 16; ++j) { const v4u q = *(const LAS v4u*)(rowl + (j * 64 + lane) * 4);
                CNT_GT(g0, q.x, thr); CNT_GT(g0, q.y, thr); CNT_GT(g0, q.z, thr); CNT_GT(g0, q.w, thr); }
            int need = TOPK - WAVE_COUNT(g0);
#pragma unroll 1
            for (int j = 0; j < 16; ++j) { const v4u q = *(const LAS v4u*)(rowl + (j * 64 + lane) * 4);
#pragma unroll
                for (int e = 0; e < 4; ++e) {
                    const unsigned long long eq = __ballot(q[e] == thr); unsigned long long bal = __ballot(q[e] > thr);
                    if (eq != 0ull && need > 0) { const int pc = __popcll(eq);
                        if (pc <= need) { bal |= eq; need -= pc; }
                        else { const int rank = __popcll(eq & ((1ull << lane) - 1ull)); bal |= __ballot(((eq >> lane) & 1ull) && rank < need); need = 0; } }
                    if (lane == 4 * j + e) myword = bal; } }
            }
        }
        ((unsigned long long*)(ws + WS_MASK))[(size_t)(b * SEQ + t) * 64 + lane] = myword;
    }
#undef WAVE_COUNT
#undef WAVE_COUNT3
#undef CNT_GE
#undef CNT_GT
}

__device__ __forceinline__ void fox_bias_scan(const float* logf_bh, char* lds, const Frame& F) {
    const int tid = F.tid, lane = F.lane, w = F.wave;
    float* wsum = (float*)(lds + att::LDS_WS);
    float v[8];
    { const f32x4 a = *(const f32x4*)(logf_bh + 8 * tid), c = *(const f32x4*)(logf_bh + 8 * tid + 4); v[0] = a.x; v[1] = a.y; v[2] = a.z; v[3] = a.w; v[4] = c.x; v[5] = c.y; v[6] = c.z; v[7] = c.w; }
#pragma unroll
    for (int j = 1; j < 8; ++j) v[j] += v[j - 1];
    float inc = v[7];
#pragma unroll
    for (int o = 1; o < 64; o <<= 1) { const float t = __shfl_up(inc, o); if (lane >= o) inc += t; }
    if (lane == 63) wsum[w] = inc;
    __syncthreads();
    float off = inc - v[7];
    for (int k = 0; k < w; ++k) off += wsum[k];
    float* bias = (float*)(lds + att::LDS_BIAS);
    constexpr float NIS = -1.0f / att::SCALE;
    f32x4 o0, o1; o0.x = (off + v[0]) * NIS; o0.y = (off + v[1]) * NIS; o0.z = (off + v[2]) * NIS; o0.w = (off + v[3]) * NIS;
    o1.x = (off + v[4]) * NIS; o1.y = (off + v[5]) * NIS; o1.z = (off + v[6]) * NIS; o1.w = (off + v[7]) * NIS;
    *(f32x4*)(bias + 8 * tid) = o0; *(f32x4*)(bias + 8 * tid + 4) = o1;
    __syncthreads();
}
__device__ __forceinline__ att::BlockRef make_ref(const Args& A, int kind, int item, int pass) {
    unsigned char* ws = A.ws; att::BlockRef r;
    if (kind < 2) { const int bh = item >> 3, x = item & 7, qb = pass ? 15 - x : x, b = bh / 6, h = bh % 6;
        const size_t ho = ((size_t)bh * SEQ) * HD;
        r.Q = (const bf16*)(ws + (kind ? WS_QD : WS_QF)) + ho + (size_t)qb * 256 * HD; r.K = (const bf16*)(ws + (kind ? WS_KD : WS_KF)) + ho; r.V = (const bf16*)(ws + (kind ? WS_VD : WS_VF)) + ho;
        r.O = (bf16*)(ws + WS_OF) + ((size_t)(b * SEQ + qb * 256)) * DM + (kind ? FOXW : 0) + h * HD; r.P0 = qb * 256;
        r.mrow = (const unsigned long long*)(ws + WS_MASK) + (size_t)(b * SEQ + qb * 256) * 64; }
    else { const int bh = item >> 3, x = item & 7, qb = 2 * x + pass, b = bh / 4, h = bh % 4;
        r.Q = (const bf16*)(ws + WS_QC) + ((size_t)bh * SEQ + (size_t)qb * 256) * HD; r.K = (const bf16*)(ws + WS_KC) + (size_t)bh * NMEM * HD; r.V = (const bf16*)(ws + WS_VC) + (size_t)bh * NMEM * HD;
        r.O = (bf16*)(ws + WS_OF) + ((size_t)(b * SEQ + qb * 256)) * DM + FOXW + DSAW + h * HD; r.P0 = 1 << 20; r.mrow = nullptr; }
    return r;
}
template <int MODE, int KIND>
__device__ __forceinline__ void attn_stream(const Args& A, const Frame& F, char* lds, int first, int nitems) {
    constexpr int W = 1 << 30; constexpr int SKV = KIND == 2 ? NMEM : SEQ; constexpr int LDO = DM;
    int L = first; if (L >= nitems) return;
    int pass = 0, cur_bh = -1;
    att::BlockRef cur = make_ref(A, KIND, L, 0);
    att::Seam S;
    att::attn_prime(cur, W, lds, S);
    for (;;) {
        const bool more_pass = pass == 0, more_item = L + F.G < nitems, last = !more_pass && !more_item;
        int passn = pass + 1, Ln = L;
        if (!more_pass) { passn = 0; Ln = more_item ? L + F.G : L; }
        const att::BlockRef nxt = last ? cur : make_ref(A, KIND, Ln, passn);
        if constexpr (MODE == 1) { const int bh = L >> 3; if (bh != cur_bh) { fox_bias_scan((const float*)(A.ws + WS_LOGF) + (size_t)bh * SEQ, lds, F); cur_bh = bh; } }
        att::attn_block<MODE>(cur, nxt, SKV, W, LDO, lds, S);
        if (last) break;
        cur = nxt; pass = passn; L = Ln;
    }
}

struct SchedRows {
    int G, c, nN, K; const char* Ap; const char* Bp;
    __device__ __forceinline__ bool next(int i, pg8::Unit& u) const { const int L = i * G + c; if (L >= 32 * nN) return false; pg8::tile_order(L, 32, nN, u.pm, u.pn); u.e = 0; u.aux = 0; return true; }
    __device__ __forceinline__ const char* abase() const { return Ap; }
    __device__ __forceinline__ unsigned arow_off(const pg8::Unit& u, int r) const { return (unsigned)(u.pm * 256 + r) * (unsigned)(K * 2); }
    __device__ __forceinline__ const char* bbase(const pg8::Unit& u) const { return Bp + (size_t)u.pn * 256 * K * 2; }
};
__device__ __forceinline__ pg8::f32x4 gate4(const bf16* p) { const v2u gw = *(const v2u*)p; pg8::f32x4 g; g[0] = bflo(gw.x); g[1] = bfhi(gw.x); g[2] = bflo(gw.y); g[3] = bfhi(gw.y); return g; }
struct HookMerge {
    static constexpr bool ENABLED = true; const bf16* PROJ;
    __device__ __forceinline__ bool at(int t) const { return t == 12 || t == 24; }
    __device__ __forceinline__ void operator()(pg8::f32x4 (&acc)[2][2][4][2], const pg8::Unit& u, int wr, int wc, int fr, int fq, int t) const {
        asm volatile("" : "+v"(fr), "+v"(fq));
        const int row0 = u.pm * 256 + wr * 64 + fr, col0 = u.pn * 256 + wc * 32 + 8 * fq, ga = (t == 12) ? 0 : 1;
#pragma unroll
        for (int ai = 0; ai < 2; ++ai)
#pragma unroll
            for (int m = 0; m < 4; ++m) { const bf16* gp = PROJ + (size_t)(row0 + ai * 128 + m * 16) * N1 + C_G + ga * DM + col0;
#pragma unroll
                for (int bj = 0; bj < 2; ++bj) { const v4u ea = *(const v4u*)(gp + bj * 128), eb = *(const v4u*)(gp + DM + bj * 128);
#pragma unroll
                    for (int n = 0; n < 2; ++n) { const unsigned a0 = n ? ea.z : ea.x, a1 = n ? ea.w : ea.y, b0 = n ? eb.z : eb.x, b1 = n ? eb.w : eb.y;
                        acc[ai][bj][m][n][0] *= bflo(b0) * __builtin_amdgcn_rcpf(bflo(a0)); acc[ai][bj][m][n][1] *= bfhi(b0) * __builtin_amdgcn_rcpf(bfhi(a0));
                        acc[ai][bj][m][n][2] *= bflo(b1) * __builtin_amdgcn_rcpf(bflo(a1)); acc[ai][bj][m][n][3] *= bfhi(b1) * __builtin_amdgcn_rcpf(bfhi(a1)); } }
                if (m == 3) asm volatile("" ::: "memory"); }
    }
};
struct Epi3 {
    static constexpr bool PERM = true;
    const bf16* PROJ; bf16* MERGED;
    __device__ __forceinline__ void operator()(const pg8::f32x4 (&acc)[2][2][4][2], const pg8::Unit& u, int wr, int wc, int fr, int fq) const {
        asm volatile("" : "+v"(fr), "+v"(fq));
        const int row0 = u.pm * 256 + wr * 64 + fr, col0 = u.pn * 256 + wc * 32 + 8 * fq;
#pragma unroll
        for (int ai = 0; ai < 2; ++ai)
#pragma unroll
            for (int m = 0; m < 4; ++m) { const size_t row = (size_t)(row0 + ai * 128 + m * 16);
#pragma unroll
                for (int bj = 0; bj < 2; ++bj) { const int col = col0 + bj * 128; const v4u e = *(const v4u*)(PROJ + row * N1 + C_G + 2 * DM + col);
                    const pg8::f32x4 v0 = acc[ai][bj][m][0], v1 = acc[ai][bj][m][1]; v4u w;
                    w.x = pg8::cvt_pk_bf16(v0[0] * __builtin_amdgcn_rcpf(bflo(e.x)), v0[1] * __builtin_amdgcn_rcpf(bfhi(e.x))); w.y = pg8::cvt_pk_bf16(v0[2] * __builtin_amdgcn_rcpf(bflo(e.y)), v0[3] * __builtin_amdgcn_rcpf(bfhi(e.y)));
                    w.z = pg8::cvt_pk_bf16(v1[0] * __builtin_amdgcn_rcpf(bflo(e.z)), v1[1] * __builtin_amdgcn_rcpf(bfhi(e.z))); w.w = pg8::cvt_pk_bf16(v1[2] * __builtin_amdgcn_rcpf(bflo(e.w)), v1[3] * __builtin_amdgcn_rcpf(bfhi(e.w)));
                    *(v4u*)(MERGED + row * DM + col) = w; } }
    }
};
struct Epi4 {
    static constexpr bool PERM = true;
    const float* X; float* OUT; bf16* X1G; const float* gffn; float* rowss;
    __device__ __forceinline__ void operator()(const pg8::f32x4 (&acc)[2][2][4][2], const pg8::Unit& u, int wr, int wc, int fr, int fq) const {
        const int row0 = u.pm * 256 + wr * 64 + fr, col0 = u.pn * 256 + wc * 32 + 8 * fq;
#pragma unroll
        for (int ai = 0; ai < 2; ++ai)
#pragma unroll
            for (int m = 0; m < 4; ++m) { const size_t row = (size_t)(row0 + ai * 128 + m * 16); float ss = 0.f;
#pragma unroll
                for (int bj = 0; bj < 2; ++bj) { const int col = col0 + bj * 128;
                    const pg8::f32x4 xa = *(const pg8::f32x4*)(X + row * DM + col) + acc[ai][bj][m][0], xb = *(const pg8::f32x4*)(X + row * DM + col + 4) + acc[ai][bj][m][1];
                    *(pg8::f32x4*)(OUT + row * DM + col) = xa; *(pg8::f32x4*)(OUT + row * DM + col + 4) = xb;
                    ss += ((xa[0] * xa[0] + xa[1] * xa[1]) + (xa[2] * xa[2] + xa[3] * xa[3])) + ((xb[0] * xb[0] + xb[1] * xb[1]) + (xb[2] * xb[2] + xb[3] * xb[3]));
                    const pg8::f32x4 ga = *(const pg8::f32x4*)(gffn + col), gb = *(const pg8::f32x4*)(gffn + col + 4);
                    v4u w; w.x = pg8::cvt_pk_bf16(xa[0] * ga[0], xa[1] * ga[1]); w.y = pg8::cvt_pk_bf16(xa[2] * ga[2], xa[3] * ga[3]);
                    w.z = pg8::cvt_pk_bf16(xb[0] * gb[0], xb[1] * gb[1]); w.w = pg8::cvt_pk_bf16(xb[2] * gb[2], xb[3] * gb[3]); *(v4u*)(X1G + row * DM + col) = w; }
                ss += __shfl_xor(ss, 16); ss += __shfl_xor(ss, 32);
                if (fq == 0) atomicAdd(rowss + row, ss); }
    }
};
typedef float f32x16r __attribute__((ext_vector_type(16)));
__device__ __forceinline__ void router_block(const Args& A, const Frame& F, LAS unsigned char* lds, int tok0) {
    unsigned char* ws = A.ws; const float* X1 = A.out; const float* rowss = (const float*)(ws + WS_CTL) + CW_ROWSS;
    int lane = F.lane; asm volatile("" : "+v"(lane));
    const int w = F.wave, i = lane & 31, kk = lane >> 5;
    f32x16r acc0 = {}, acc1 = {};
    LAS float* Bs = (LAS float*)(lds + 65536 + 8192);
    const float rss = (F.tid < 32) ? rowss[tok0 + F.tid] : 0.f;
    if (F.tid < 36) Bs[F.tid] = (F.tid < 32) ? A.router_expert_b[F.tid] : A.router_group_b[F.tid - 32];
    const float* gp = A.ffn_norm_g + 256 * w;
    const float* We = A.router_expert_w + (size_t)(256 * w) * NEXP + i;
    const float* Wg = A.router_group_w + (size_t)(256 * w) * NGRP + (i & 3);
    LAS float* xs = (LAS float*)(lds + w * 8192);
    const int xr0 = lane >> 3, xc4 = (lane & 7) * 4;
    const float* xg = X1 + (size_t)(tok0 + xr0) * DM + 256 * w + xc4;
    f32x4 ra[4];
#pragma unroll
    for (int j = 0; j < 4; ++j) ra[j] = *(const f32x4*)(xg + (size_t)(8 * j) * DM) * *(const f32x4*)(gp + xc4);
#pragma unroll 1
    for (int ch = 0; ch < 8; ++ch) {
#pragma unroll
        for (int j = 0; j < 4; ++j) *(LAS f32x4*)(xs + (xr0 + 8 * j) * 36 + xc4) = ra[j];
        if (ch + 1 < 8) {
#pragma unroll
            for (int j = 0; j < 4; ++j) ra[j] = *(const f32x4*)(xg + (size_t)(8 * j) * DM + 32 * (ch + 1)) * *(const f32x4*)(gp + 32 * (ch + 1) + xc4); }
#pragma unroll
        for (int kq = 0; kq < 8; ++kq) {
            const int k0 = 32 * ch + 4 * kq + kk;
            const float a0 = xs[i * 36 + 4 * kq + kk], a1 = xs[i * 36 + 4 * kq + 2 + kk];
            const float b00 = We[(size_t)k0 * NEXP], b01 = We[(size_t)(k0 + 2) * NEXP];
            float b10 = Wg[(size_t)k0 * NGRP], b11 = Wg[(size_t)(k0 + 2) * NGRP];
            if (i >= 4) { b10 = 0.f; b11 = 0.f; }
            acc0 = __builtin_amdgcn_mfma_f32_32x32x2f32(a0, b00, acc0, 0, 0, 0);
            acc1 = __builtin_amdgcn_mfma_f32_32x32x2f32(a0, b10, acc1, 0, 0, 0);
            acc0 = __builtin_amdgcn_mfma_f32_32x32x2f32(a1, b01, acc0, 0, 0, 0);
            acc1 = __builtin_amdgcn_mfma_f32_32x32x2f32(a1, b11, acc1, 0, 0, 0);
        }
    }
    LAS float* P = (LAS float*)lds;
    LAS float* R = (LAS float*)(lds + 65536);
#pragma unroll
    for (int r = 0; r < 16; ++r) { const int trow = (r & 3) + 8 * (r >> 2) + 4 * kk;
        P[(w * 32 + trow) * 64 + i] = acc0[r]; P[(w * 32 + trow) * 64 + 32 + i] = acc1[r]; }
    __syncthreads();
    for (int idx = F.tid; idx < 2048; idx += NTHREADS) { float s = 0.f;
#pragma unroll
        for (int q = 0; q < 8; ++q) s += P[q * 2048 + idx];
        R[idx] = s; }
    __syncthreads();
    if (F.tid < 32) {
        const int tok = tok0 + F.tid; const LAS float* lr = R + F.tid * 64;
        const float rs = 1.0f / sqrtf(rss * (1.f / DM) + EPS);
        float gl[4];
#pragma unroll
        for (int o = 0; o < 4; ++o) gl[o] = lr[32 + o] * rs + Bs[32 + o];
        int grp = 0; float gmax = gl[0];
#pragma unroll
        for (int o = 1; o < 4; ++o) if (gl[o] > gmax) { gmax = gl[o]; grp = o; }
        float den = 0.f;
#pragma unroll
        for (int o = 0; o < 4; ++o) den += expf(gl[o] - gmax);
        const float psel = 1.0f / den;
        float el[8];
#pragma unroll
        for (int j = 0; j < 8; ++j) el[j] = lr[grp * 8 + j] * rs + Bs[grp * 8 + j];
        int j1 = 0; float l1 = el[0];
#pragma unroll
        for (int j = 1; j < 8; ++j) if (el[j] > l1) { l1 = el[j]; j1 = j; }
        int j2 = -1; float l2 = -__builtin_inff();
#pragma unroll
        for (int j = 0; j < 8; ++j) if (j != j1 && el[j] > l2) { l2 = el[j]; j2 = j; }
        const float e2 = expf(l2 - l1); const float g1 = psel / (1.0f + e2), g2 = psel * e2 / (1.0f + e2);
        unsigned* cnt = (unsigned*)(ws + WS_CTL) + CW_CNT; int* LTOK = (int*)(ws + WS_LTOK); float* LGATE = (float*)(ws + WS_LGATE);
        const int e1i = grp * 8 + j1, e2i = grp * 8 + j2;
        float* LRS = (float*)(ws + WS_LRS);
        const unsigned p1 = atomicAdd(cnt + e1i, 1u), p2 = atomicAdd(cnt + e2i, 1u);
        LTOK[(size_t)e1i * MTOK + p1] = tok * 2; LGATE[(size_t)e1i * MTOK + p1] = g1; LRS[(size_t)e1i * MTOK + p1] = rs;
        LTOK[(size_t)e2i * MTOK + p2] = tok * 2 + 1; LGATE[(size_t)e2i * MTOK + p2] = g2; LRS[(size_t)e2i * MTOK + p2] = rs;
    }
    __syncthreads();
}
__device__ __forceinline__ void moe_tables(const Args& A, LAS unsigned char* lds, const Frame& F) {
    LAS int* T = (LAS int*)(lds + LDSCTL_OFF);
    if (F.tid < 64) {
        const unsigned* cnt = (const unsigned*)(A.ws + WS_CTL) + CW_CNT; const int e = F.tid;
        const int c = e < NEXP ? (int)__hip_atomic_load(cnt + e, __ATOMIC_RELAXED, __HIP_MEMORY_SCOPE_AGENT) : 0; const int mt = (c + 255) >> 8;
        int inc = mt;
#pragma unroll
        for (int o = 1; o < 32; o <<= 1) { const int v = __shfl_up(inc, o); if ((e & 31) >= o) inc += v; }
        const int excl = inc - mt;
        if (e < NEXP) { T[e] = excl * 16; T[40 + e] = excl * 256; T[80 + e] = c; }
        if (e == NEXP - 1) { T[32] = inc * 16; T[72] = inc * 256; }
    }
    __syncthreads();
}
struct SchedMoeLC {
    int G, c, K; int mode;
    const char* Ap; const float* W0; const float* W1; const int* LTOK; const LAS int* T; bool dbg_same;
    __device__ __forceinline__ bool next(int i, pg8::Unit& u) const {
        const int L = i * G + c; if (L >= T[32]) return false;
        int e = 0;
#pragma unroll 1
        for (int s = 16; s >= 1; s >>= 1) if (T[e + s] <= L) e += s;
        const int l = L - T[e], mte = (T[e + 1] - T[e]) >> 4; u.e = e; u.pn = l / mte; u.pm = l - u.pn * mte; u.aux = T[80 + e] - u.pm * 256;
        return true;
    }
    __device__ __forceinline__ const char* abase() const { return Ap; }
    __device__ __forceinline__ unsigned arow_off(const pg8::Unit& u, int r) const {
        if (mode == 0) { const int tok = (r < u.aux) ? (LTOK[(size_t)u.e * MTOK + u.pm * 256 + r] >> 1) : 0; return (unsigned)tok * (unsigned)(K * 2); }
        return (unsigned)(T[40 + u.e] + u.pm * 256 + r) * (unsigned)(K * 2);
    }
    __device__ __forceinline__ int bpitch() const { return mode == 0 ? FF : DM; }
    __device__ __forceinline__ const float* bsrc(const pg8::Unit& u, int c4) const {
        if (dbg_same) { const int q = c4 >> 5, within = c4 & 31; return ((within < 16) ? W0 : W1) + 16 * q + (within & 15); }
        if (mode == 0) { const int q = c4 >> 5, within = c4 & 31; return ((within < 16) ? W0 : W1) + (size_t)u.e * DM * FF + 64 * u.pn + 16 * q + (within & 15); }
        return W0 + (size_t)u.e * FF * DM + 128 * u.pn + c4;
    }
};
struct Epi6 {
    bf16* HID; const float* LRS; const LAS int* T;
    struct Pre { float rs[4]; };
    __device__ __forceinline__ void prefetch(Pre& p, const pg8::Unit& u, int cw, int fr) const {
#pragma unroll
        for (int m = 0; m < 4; ++m) { const int r = cw * 64 + m * 16 + fr; p.rs[m] = (r < u.aux) ? LRS[(size_t)u.e * MTOK + u.pm * 256 + r] : 0.f; }
    }
    __device__ __forceinline__ void operator()(const pg8::f32x4 (&acc)[4][8], const pg8::Unit& u, int cw, int fr, int fq, const Pre& p, LAS unsigned char* stg) const {
        const int sb = T[40 + u.e] + u.pm * 256; const int L = fr + 16 * fq;
#pragma unroll
        for (int m = 0; m < 4; ++m) {
            const float rs = p.rs[m];
#pragma unroll
            for (int q = 0; q < 4; ++q) { const pg8::f32x4 g = acc[m][2 * q] * rs, up = acc[m][2 * q + 1] * rs; pg8::f32x4 hv;
#pragma unroll
                for (int j = 0; j < 4; ++j) hv[j] = g[j] * __builtin_amdgcn_rcpf(1.0f + __expf(-g[j])) * up[j];
                v2u w; w.x = pg8::cvt_pk_bf16(hv[0], hv[1]); w.y = pg8::cvt_pk_bf16(hv[2], hv[3]);
                *(LAS v2u*)(stg + fr * 144 + (q * 16 + 4 * fq) * 2) = w; }
#pragma unroll
            for (int i = 0; i < 2; ++i) { const int row = 8 * i + (L >> 3), c = L & 7;
                const v4u x = *(const LAS v4u*)(stg + row * 144 + c * 16);
                *(v4u*)(HID + (size_t)(sb + cw * 64 + m * 16 + row) * FF + u.pn * 64 + c * 8) = x; } }
    }
};
struct Epi7 {
    bf16* Y; const int* LTOK; const float* LGATE;
    struct Pre { int aid[4]; float gate[4]; };
    __device__ __forceinline__ void prefetch(Pre& p, const pg8::Unit& u, int cw, int fr) const {
#pragma unroll
        for (int m = 0; m < 4; ++m) { const int r = cw * 64 + m * 16 + fr; const size_t li = (size_t)u.e * MTOK + u.pm * 256 + (r < u.aux ? r : 0); p.aid[m] = LTOK[li]; p.gate[m] = LGATE[li]; }
    }
    __device__ __forceinline__ void operator()(const pg8::f32x4 (&acc)[4][8], const pg8::Unit& u, int cw, int fr, int fq, const Pre& p, LAS unsigned char* stg) const {
        const int L = fr + 16 * fq;
#pragma unroll
        for (int m = 0; m < 4; ++m) {
            if (cw * 64 + m * 16 >= u.aux) break;
            const float gate = p.gate[m];
#pragma unroll
            for (int n = 0; n < 8; ++n) { const pg8::f32x4 v = acc[m][n] * gate; v2u w; w.x = pg8::cvt_pk_bf16(v[0], v[1]); w.y = pg8::cvt_pk_bf16(v[2], v[3]);
                *(LAS v2u*)(stg + fr * 272 + (n * 16 + 4 * fq) * 2) = w; }
#pragma unroll
            for (int i = 0; i < 4; ++i) { const int row = 4 * i + (L >> 4), c = L & 15;
                const int aid = __shfl(p.aid[m], row);
                const v4u x = *(const LAS v4u*)(stg + row * 272 + c * 16);
                if (cw * 64 + m * 16 + row < u.aux) *(v4u*)(Y + (size_t)aid * DM + u.pn * 128 + c * 8) = x; } }
    }
};


#ifdef MK_DIAG
__device__ __forceinline__ float blk_reduce(float v, bool ismax, LAS float* red, int tid) {
    for (int o = 1; o < 64; o <<= 1) { const float t = __shfl_xor(v, o); v = ismax ? fmaxf(v, t) : v + t; }
    __syncthreads(); if ((tid & 63) == 0) red[tid >> 6] = v; __syncthreads();
    float r = red[0]; for (int i = 1; i < 8; ++i) r = ismax ? fmaxf(r, red[i]) : r + red[i];
    __syncthreads(); return r;
}
__device__ __forceinline__ void diag_row(const Args& A, LAS unsigned char* lds, int b, int t, int tid) {
    unsigned char* ws = A.ws; const int row = b * SEQ + t; float* ctl = (float*)(ws + WS_CTL) + 512;
    LAS float* sc = (LAS float*)lds; LAS float* lg = sc + 4096; LAS float* cum = lg + 4096; LAS float* red = cum + 4096; LAS float* ov = red + 64; LAS unsigned char* sel = (LAS unsigned char*)(ov + 512);
    const bf16* OUTR = (const bf16*)(ws + WS_OF) + (size_t)row * DM;
    for (int s = tid; s < SEQ; s += NTHREADS) { float v = -__builtin_inff();
        if (s <= t) { v = 0.f; for (int j = 0; j < IDXH; ++j) { float d = 0.f;
                for (int k = 0; k < IDXD; ++k) { const int srow = b * SEQ + s; d += bf2f(((const bf16*)(ws + WS_QI))[(size_t)row * 1024 + j * 64 + k]) * bf2f(((const bf16*)(ws + WS_KI))[((size_t)(srow >> 5) * 8 + (k >> 3)) * 256 + (srow & 31) * 8 + (k & 7)]); }
                v += ((const float*)(ws + WS_WI))[(size_t)row * IDXH + j] * fmaxf(d, 0.f); } }
        sc[s] = v; }
    __syncthreads();
    for (int s = tid; s < SEQ; s += NTHREADS) { int rank = 0; const float v = sc[s];
        if (s <= t) { for (int q = 0; q <= t; ++q) { const float u = sc[q]; rank += (u > v || (u == v && q < s)) ? 1 : 0; } }
        sel[s] = (s <= t && rank < TOPK) ? 1 : 0; }
    __syncthreads();
    float sd[3] = {0.f, 0.f, 0.f}, sr[3] = {0.f, 0.f, 0.f};
    for (int kind = 0; kind < 3; ++kind) {
        const int nh = kind == 2 ? 4 : 6, nk = kind == 2 ? NMEM : t + 1;
        if (kind == 0 && tid == 0) { }
        for (int h = 0; h < nh; ++h) {
            const bf16* Q; const bf16* K; const bf16* V; int ocol;
            if (kind == 0) { const size_t ho = (size_t)(b * 6 + h) * SEQ * HD; Q = (const bf16*)(ws + WS_QF) + ho + (size_t)t * HD; K = (const bf16*)(ws + WS_KF) + ho; V = (const bf16*)(ws + WS_VF) + ho; ocol = h * HD; }
            else if (kind == 1) { const size_t ho = (size_t)(b * 6 + h) * SEQ * HD; Q = (const bf16*)(ws + WS_QD) + ho + (size_t)t * HD; K = (const bf16*)(ws + WS_KD) + ho; V = (const bf16*)(ws + WS_VD) + ho; ocol = FOXW + h * HD; }
            else { Q = (const bf16*)(ws + WS_QC) + ((size_t)(b * 4 + h) * SEQ + t) * HD; K = (const bf16*)(ws + WS_KC) + (size_t)(b * 4 + h) * NMEM * HD; V = (const bf16*)(ws + WS_VC) + (size_t)(b * 4 + h) * NMEM * HD; ocol = FOXW + DSAW + h * HD; }
            if (kind == 0) { if (tid == 0) { float c = 0.f; const float* lf = (const float*)(ws + WS_LOGF) + (size_t)(b * 6 + h) * SEQ; for (int s = 0; s < SEQ; ++s) { c += lf[s]; cum[s] = c; } } __syncthreads(); }
            float mx = -__builtin_inff();
            for (int s = tid; s < SEQ; s += NTHREADS) { float v = -__builtin_inff();
                if (s < nk && (kind != 1 || sel[s])) { float d = 0.f; for (int k = 0; k < HD; ++k) d += bf2f(Q[k]) * bf2f(K[(size_t)s * HD + k]); v = d * att::SCALE; if (kind == 0) v += cum[t] - cum[s]; }
                lg[s] = v; mx = fmaxf(mx, v); }
            mx = blk_reduce(mx, true, red, tid);
            float sm = 0.f;
            for (int s = tid; s < SEQ; s += NTHREADS) { const float p = (lg[s] == -__builtin_inff()) ? 0.f : expf(lg[s] - mx); lg[s] = p; sm += p; }
            sm = blk_reduce(sm, false, red, tid);
            { const int d = tid & 127, part = tid >> 7; float o = 0.f;
              for (int s = part; s < nk; s += 4) { const float p = lg[s]; if (p != 0.f) o += p * bf2f(V[(size_t)s * HD + d]); }
              ov[tid] = o; }
            __syncthreads();
            if (tid < 128) { const float o = (ov[tid] + ov[128 + tid] + ov[256 + tid] + ov[384 + tid]) / sm; const float g = bf2f(OUTR[ocol + tid]); sd[kind] += (g - o) * (g - o); sr[kind] += o * o; }
            __syncthreads();
        }
    }
    for (int kind = 0; kind < 3; ++kind) { const float a = blk_reduce(sd[kind], false, red, tid), c = blk_reduce(sr[kind], false, red, tid); if (tid == 0) { atomicAdd(ctl + 2 * kind, a); atomicAdd(ctl + 2 * kind + 1, c); } }
}
#endif
constexpr int NPHASES = 11;
__global__ void __launch_bounds__(NTHREADS, 2) mk_fwd(Args A) {
    extern __shared__ __attribute__((aligned(16))) unsigned char lds[];
    cg::grid_group grid = cg::this_grid();
    Frame F; F.tid = threadIdx.x; F.lane = F.tid & 63; F.wave = __builtin_amdgcn_readfirstlane(F.tid >> 6); F.G = gridDim.x; F.c = blockIdx.x;
    F.vcu = (F.G % 8 == 0) ? (F.c % 8) * (F.G / 8) + F.c / 8 : F.c;
    LAS unsigned char* L3 = (LAS unsigned char*)lds;
    unsigned char* ws = A.ws;
    const int lo = A.ph_lo, hi = A.ph_hi;
#ifndef PHASE_MASK
#define PHASE_MASK 0xFFFF
#endif
#define IN(k) (((PHASE_MASK >> (k)) & 1) && lo <= (k) && (k) < hi)
#define REFRESH0() do {} while (0)
    volatile LAS unsigned* xst = (volatile LAS unsigned*)(L3 + LDSCTL_OFF + 1024);
    if (F.tid < 4) xst[F.tid] = 0u;
    __syncthreads();
    XcdBarrier xbar;
    if (lo > 0 || MK_N_LAUNCHES != 1) xbar = xcd_barrier_post((unsigned*)(ws + WS_CTL) + CW_BAR, xst);
#define SEAM(k) do { if (IN(k) && IN((k) + 1)) { if ((k) == 0) grid.sync(); else xcd_barrier(xbar); } } while (0)
    const int gw = F.vcu * NWAVES + F.wave, NGW = F.G * NWAVES;

    if (IN(0)) {
        if (MK_N_LAUNCHES == 1) { unsigned* ctl = (unsigned*)(ws + WS_CTL);
            for (int iw = F.c * NTHREADS + F.tid; iw < (int)(CTL_ZERO_BYTES / 4); iw += F.G * NTHREADS) ctl[iw] = 0u; }
        p0_prologue(A, F, L3); } SEAM(0);
    if (lo == 0 && MK_N_LAUNCHES == 1) xbar = xcd_barrier_post((unsigned*)(ws + WS_CTL) + CW_BAR, xst);
    if (IN(1)) {
        Sched1 S{F.G, F.c, (const char*)(ws + WS_H), (const char*)(ws + WS_WIN), (const char*)(ws + WS_WMKV), (unsigned)(WS_MEMN - WS_H), false};
        Epi1 E{(bf16*)(ws + WS_PROJ), (bf16*)(ws + WS_MKV), (bf16*)(ws + WS_VF), (bf16*)(ws + WS_VD), L3 + LDSCTL_OFF + 4096};
        pg8::gemm_phase<Epi1, Sched1, true, true>(L3, DM, S, E);
    } SEAM(1);
    if (IN(2)) {
        const RopeFreq RF = rope_freqs(F.lane);
        { P1bRow Rc, Rn; int r = gw;
          if (r < MTOK) p1b_load(A, r, F.lane, Rc);
#pragma unroll 1
          while (r < MTOK) {
              const int rn = r + NGW; p1b_load(A, rn < MTOK ? rn : r, F.lane, Rn);
              p1b_row(A, r, F.lane, RF, Rc); r = rn; Rc = Rn; }
          for (; r < MTOK + BATCH * NMEM; r += NGW) p1b_memrow(A, r - MTOK, F.lane); }
    } SEAM(2);
    if (IN(3)) {
        for (int it = F.c; it < 256; it += F.G) { const int b = it >> 7, y = it & 127; indexer_block(A, F, L3, b, y); indexer_block(A, F, L3, b, 255 - y); }
    } SEAM(3);
    if (IN(4)) {
        const int G = F.G, v = F.vcu;
        attn_stream<1, 0>(A, F, (char*)lds, v, 96);
        attn_stream<2, 1>(A, F, (char*)lds, (v + G - (96 % G)) % G, 96);
        attn_stream<3, 2>(A, F, (char*)lds, (v + G - (192 % G)) % G, 64);
        { const int ci = (v + G - (192 % G)) % G;
          Sched1 S{G, ci, (const char*)(ws + WS_H), (const char*)(ws + WS_WIN), (const char*)(ws + WS_WMKV), (unsigned)(WS_MEMN - WS_H), true};
          Epi1 E{(bf16*)(ws + WS_PROJ), (bf16*)(ws + WS_MKV), (bf16*)(ws + WS_VF), (bf16*)(ws + WS_VD), L3 + LDSCTL_OFF + 4096};
          pg8::gemm_phase<Epi1, Sched1, true, true>(L3, DM, S, E);
          if (ci < 64) p0_items(A, F, L3, ci * NWAVES + F.wave, 64 * NWAVES, P0_T1, P0_T5); }
    } SEAM(4);
    if (IN(5)) {
        SchedRows S{F.G, F.c, 8, DM, (const char*)(ws + WS_OF), (const char*)(ws + WS_WBF)}; Epi3 E{(const bf16*)(ws + WS_PROJ), (bf16*)(ws + WS_MERGED)}; HookMerge H{(const bf16*)(ws + WS_PROJ)};
        pg8::gemm_phase<Epi3, SchedRows, true, true, HookMerge>(L3, DM, S, E, H);
    } SEAM(5);
    if (IN(6)) {
        SchedRows S{F.G, F.c, 8, DM, (const char*)(ws + WS_MERGED), (const char*)(ws + WS_WOUT)};
        Epi4 E{A.x, A.out, (bf16*)(ws + WS_X1G), A.ffn_norm_g, (float*)(ws + WS_CTL) + CW_ROWSS};
        pg8::gemm_phase<Epi4, SchedRows, true, true>(L3, DM, S, E);
    } SEAM(6);
    if (IN(7)) { for (int it = F.c; it < MTOK / 32; it += F.G) router_block(A, F, L3, it * 32); } SEAM(7);
    if (IN(8)) {
        moe_tables(A, L3, F);
        const bool dbg = (A.flags & 4) != 0;
        SchedMoeLC S{F.G, F.vcu, DM, 0, (const char*)(ws + WS_X1G), A.expert_w_gate, A.expert_w_up, (const int*)(ws + WS_LTOK), (const LAS int*)(L3 + LDSCTL_OFF), dbg};
        Epi6 E{(bf16*)(ws + (dbg ? WS_WGU : WS_HID)), (const float*)(ws + WS_LRS), (const LAS int*)(L3 + LDSCTL_OFF)};
        lc::gemm_lc<Epi6, SchedMoeLC>(L3, DM, S, E);
    } SEAM(8);
    if (IN(9)) {
        if (!IN(8)) moe_tables(A, L3, F);
        SchedMoeLC S{F.G, F.vcu, FF, 1, (const char*)(ws + WS_HID), A.expert_w_down, nullptr, (const int*)(ws + WS_LTOK), (const LAS int*)(L3 + LDSCTL_OFF), false};
        Epi7 E{(bf16*)(ws + WS_Y), (const int*)(ws + WS_LTOK), (const float*)(ws + WS_LGATE)};
        lc::gemm_lc<Epi7, SchedMoeLC>(L3, FF, S, E);
    } SEAM(9);
#ifdef MK_DIAG
    if (lo == 11) { REFRESH0(); for (int it = F.c; it < 256; it += F.G) { const int b = it & 1; const int t = (it < 32) ? (it * 9 + 3) : (int)(((unsigned)it * 2654435761u >> 7) % SEQ); diag_row(A, L3, b, t, F.tid); } }
#endif
    if (IN(10)) {
        const v2u* Y = (const v2u*)(ws + WS_Y); f32x4* O = (f32x4*)A.out;
        for (size_t i = (size_t)F.c * NTHREADS + F.tid; i < (size_t)MTOK * (DM / 4); i += (size_t)F.G * NTHREADS) {
            const size_t tok = i / (DM / 4), c4 = i % (DM / 4);
            const v2u y0 = Y[(2 * tok) * (DM / 4) + c4], y1 = Y[(2 * tok + 1) * (DM / 4) + c4]; f32x4 o = O[i];
            o.x += bflo(y0.x) + bflo(y1.x); o.y += bfhi(y0.x) + bfhi(y1.x); o.z += bflo(y0.y) + bflo(y1.y); o.w += bfhi(y0.y) + bfhi(y1.y);
            O[i] = o;
        }
#ifdef MK_DIAG
        if (F.c == 0 && F.tid == 0) { const float* ctl = (const float*)(ws + WS_CTL) + 512; float e = 0.f;
            for (int k = 0; k < 3; ++k) if ((MK_DIAG >> k) & 1) e = fmaxf(e, sqrtf(ctl[2 * k] / fmaxf(ctl[2 * k + 1], 1e-30f)));
            __builtin_amdgcn_s_sleep(100); A.out[(size_t)MTOK * DM - 1] += 1000.f * e; }
#endif
    }
#undef IN
#undef SEAM
}

extern "C" void kernel_launch(void* const* d_in, const int* in_sizes, int n_in, void* d_out, int out_size, void* d_ws, size_t ws_size, hipStream_t stream) {
    static int grid = 0;
    if (grid == 0) {
        if (n_in != 27 || out_size != MTOK * DM || ws_size < WS_END) { fprintf(stderr, "kernel_launch: unexpected shapes (n_in %d out %d ws %zu need %zu)\n", n_in, out_size, ws_size, (size_t)WS_END); grid = -1; return; }
        int dev = 0, cus = 0, per_cu = 0;
        (void)hipGetDevice(&dev); (void)hipDeviceGetAttribute(&cus, hipDeviceAttributeMultiprocessorCount, dev);
        (void)hipFuncSetAttribute((const void*)mk_fwd, hipFuncAttributeMaxDynamicSharedMemorySize, LDS_BYTES);
        (void)hipOccupancyMaxActiveBlocksPerMultiprocessor(&per_cu, (const void*)mk_fwd, NTHREADS, LDS_BYTES);
        if (per_cu < 1) fprintf(stderr, "kernel_launch: occupancy query says %d blocks/CU\n", per_cu);
        (void)hipGetLastError();
        grid = cus > 0 ? cus : 256;
    }
    if (grid < 0) return;
#if MK_N_LAUNCHES != 1
    (void)hipMemsetAsync((char*)d_ws + WS_CTL, 0, CTL_ZERO_BYTES, stream);
#endif
    Args a{};
    const float** pf = (const float**)&a;
    for (int i = 0; i < 27; ++i) pf[i] = (const float*)d_in[i];
    a.positions = (const int*)d_in[2];
    a.out = (float*)d_out; a.ws = (unsigned char*)d_ws;
#if MK_N_LAUNCHES == 1
    a.ph_lo = 0; a.ph_hi = NPHASES;
    void* args[] = {&a};
    hipError_t e = hipLaunchCooperativeKernel((const void*)mk_fwd, dim3(grid), dim3(NTHREADS), args, LDS_BYTES, stream);
    if (e != hipSuccess) fprintf(stderr, "cooperative launch failed: %s (grid %d)\n", hipGetErrorString(e), grid);
#else
#ifndef EXP_REPEAT
#define EXP_REPEAT 0
#endif
#ifndef EXP_FLAGS
#define EXP_FLAGS 0
#endif
    for (int p = 0; p < NPHASES; ++p) { a.ph_lo = p; a.ph_hi = p + 1;
#ifdef MK_DIAG
        if (p == 10) { a.ph_lo = 11; a.ph_hi = 11; a.flags = 0; hipLaunchKernelGGL(mk_fwd, dim3(grid), dim3(NTHREADS), LDS_BYTES, stream, a); a.ph_lo = 10; a.ph_hi = 11; }
#endif
        for (int r = 0; r < (((EXP_REPEAT >> p) & 1) ? 2 : 1); ++r) { a.flags = r ? EXP_FLAGS : 0; hipLaunchKernelGGL(mk_fwd, dim3(grid), dim3(NTHREADS), LDS_BYTES, stream, a); } }
#endif
}
```
